# Optimizing an MI355X kernel written in HIP

```python
import jax, jax.numpy as jnp
from jax import lax
import numpy as np

D_MODEL = 1024
BATCH = 8
SEQ = 4096
DEPTH = 1

CHUNK = 64
RET_HEADS = 4
RET_QK_DIM = 256
RET_V_DIM = 256
RET_QK = RET_HEADS * RET_QK_DIM
RET_V = RET_HEADS * RET_V_DIM
POOL_WINDOWS = (2, 4, 8, 16)
POOL_GROUPS = 4
POOL_GROUP_DIM = 256
POOL_WIDTH = POOL_GROUPS * POOL_GROUP_DIM
N_BRANCH = 2
IN_WIDTH = 2 * RET_QK + 2 * RET_V + POOL_WIDTH + N_BRANCH * D_MODEL
D_FF = 2816
ROPE_BASE = 10000.0
NORM_EPS = 1e-6
FFN_RES_WEIGHT = 0.5

kernel_name = "hybrid_retention_pool_macaron"


def rmsnorm(x, g):
    xf = x.astype(jnp.float32)
    y = xf * lax.rsqrt(jnp.mean(xf * xf, axis=-1, keepdims=True) + NORM_EPS)
    return (y * g.astype(jnp.float32)).astype(x.dtype)


def swiglu_ffn(x, w_in, w_out):
    gate, up = jnp.split(x @ w_in, 2, axis=-1)
    return (jax.nn.silu(gate) * up) @ w_out


def rotary(x):
    s, d = x.shape[1], x.shape[-1]
    half = d // 2
    inv_freq = ROPE_BASE ** (-jnp.arange(half, dtype=jnp.float32) / half)
    ang = jnp.arange(s, dtype=jnp.float32)[:, None] * inv_freq[None, :]
    cos = jnp.cos(ang)[None, :, None, :].astype(x.dtype)
    sin = jnp.sin(ang)[None, :, None, :].astype(x.dtype)
    x1, x2 = x[..., :half], x[..., half:]
    return jnp.concatenate([x1 * cos - x2 * sin, x1 * sin + x2 * cos], axis=-1)


def retention(q, k, v):
    b, s, h, dk = q.shape
    dv = v.shape[-1]
    nc = s // CHUNK
    log_gamma = jnp.log(1.0 - 2.0 ** (-5.0 - jnp.arange(h, dtype=jnp.float32)))
    idx = jnp.arange(CHUNK, dtype=jnp.float32)
    inner_decay = jnp.exp(log_gamma[:, None, None] * jnp.abs(idx[:, None] - idx[None, :]))
    q_decay = jnp.exp(log_gamma[None, :] * (idx[:, None] + 1.0))
    k_decay = jnp.exp(log_gamma[None, :] * (CHUNK - 1.0 - idx[:, None]))
    chunk_decay = jnp.exp(log_gamma * CHUNK)

    qc = q.reshape(b, nc, CHUNK, h, dk)
    kc = k.reshape(b, nc, CHUNK, h, dk)
    vc = v.reshape(b, nc, CHUNK, h, dv)

    scores = jnp.einsum("bnchd,bnshd->bnhcs", qc, kc) * inner_decay[None, None]
    inner = jnp.einsum("bnhcs,bnshe->bnche", scores, vc)

    def step(state, inp):
        q_i, k_i, v_i = inp
        cross = jnp.einsum("bchd,bhde->bche", q_i * q_decay[None, :, :, None], state)
        new_state = state * chunk_decay[None, :, None, None] + jnp.einsum(
            "bchd,bche->bhde", k_i * k_decay[None, :, :, None], v_i)
        return new_state, cross

    state0 = jnp.zeros((b, h, dk, dv), jnp.float32)
    xs = (qc.transpose(1, 0, 2, 3, 4), kc.transpose(1, 0, 2, 3, 4), vc.transpose(1, 0, 2, 3, 4))
    _, cross = lax.scan(step, state0, xs)
    out = inner + cross.transpose(1, 0, 2, 3, 4)
    return out.reshape(b, s, h, dv)


def multiscale_pool(p, w_group, scale):
    b, s, _ = p.shape
    pf = p.astype(jnp.float32).reshape(b, s, POOL_GROUPS, POOL_GROUP_DIM)
    cs = jnp.concatenate([jnp.zeros((b, 1, POOL_GROUPS, POOL_GROUP_DIM), jnp.float32),
                          jnp.cumsum(pf, axis=1)], axis=1)
    t = jnp.arange(s, dtype=jnp.float32)
    outs = []
    for g, w in enumerate(POOL_WINDOWS):
        cs_g = cs[:, :, g]
        shifted = jnp.pad(cs_g[:, : s + 1 - w], ((0, 0), (w - 1, 0), (0, 0)))
        count = jnp.minimum(t + 1.0, float(w))[None, :, None]
        outs.append((cs_g[:, 1:] - shifted) / count - pf[:, :, g])
    pooled = jnp.stack(outs, axis=2)
    mixed = jnp.einsum("bsgc,gcd->bsgd", pooled, w_group.astype(jnp.float32))
    return (mixed.reshape(b, s, POOL_WIDTH) * scale.astype(jnp.float32)).astype(p.dtype)


def setup_inputs(seed: int = 0) -> dict:
    key = jax.random.key(seed)
    ks = jax.random.split(key, 20)
    f32 = jnp.float32

    def nrm(k, shape, fan_in):
        return jax.random.normal(k, shape, f32) * (fan_in ** -0.5)

    def gain(k, shape):
        return 1.0 + 0.02 * jax.random.normal(k, shape, f32)

    return {
        "x": jax.random.normal(ks[0], (BATCH, SEQ, D_MODEL), f32),
        "norm_ffn1": gain(ks[1], (DEPTH, D_MODEL)),
        "ffn1_w_in": nrm(ks[2], (DEPTH, D_MODEL, 2 * D_FF), D_MODEL),
        "ffn1_w_out": nrm(ks[3], (DEPTH, D_FF, D_MODEL), D_FF),
        "norm_mix": gain(ks[4], (DEPTH, D_MODEL)),
        "w_in": nrm(ks[5], (DEPTH, D_MODEL, IN_WIDTH), D_MODEL),
        "gate_bias": 0.02 * jax.random.normal(ks[6], (DEPTH, N_BRANCH, D_MODEL), f32),
        "pool_w": nrm(ks[7], (DEPTH, POOL_GROUPS, POOL_GROUP_DIM, POOL_GROUP_DIM), POOL_GROUP_DIM),
        "pool_scale": gain(ks[8], (DEPTH, POOL_WIDTH)),
        "w_ret_up": nrm(ks[9], (DEPTH, RET_V, D_MODEL), RET_V),
        "w_pool_up": nrm(ks[10], (DEPTH, POOL_WIDTH, D_MODEL), POOL_WIDTH),
        "w_out": nrm(ks[11], (DEPTH, D_MODEL, D_MODEL), D_MODEL),
        "norm_ffn2": gain(ks[12], (DEPTH, D_MODEL)),
        "ffn2_w_in": nrm(ks[13], (DEPTH, D_MODEL, 2 * D_FF), D_MODEL),
        "ffn2_w_out": nrm(ks[14], (DEPTH, D_FF, D_MODEL), D_FF),
        "norm_final": gain(ks[15], (D_MODEL,)),
    }


def reference(x, norm_ffn1, ffn1_w_in, ffn1_w_out, norm_mix, w_in, gate_bias, pool_w,
              pool_scale, w_ret_up, w_pool_up, w_out, norm_ffn2, ffn2_w_in, ffn2_w_out,
              norm_final):
    b, s, _ = x.shape
    split_points = [RET_QK, 2 * RET_QK, 2 * RET_QK + RET_V, 2 * RET_QK + 2 * RET_V,
                    2 * RET_QK + 2 * RET_V + POOL_WIDTH]
    h = x
    for l in range(DEPTH):
        h = h + FFN_RES_WEIGHT * swiglu_ffn(rmsnorm(h, norm_ffn1[l]), ffn1_w_in[l], ffn1_w_out[l])

        u = rmsnorm(h, norm_mix[l])
        proj = u @ w_in[l]
        q, k, v, g_ret, p, gates = jnp.split(proj, split_points, axis=-1)
        q = rotary(q.reshape(b, s, RET_HEADS, RET_QK_DIM))
        k = rotary(k.reshape(b, s, RET_HEADS, RET_QK_DIM)) * (RET_QK_DIM ** -0.5)
        v = v.reshape(b, s, RET_HEADS, RET_V_DIM)
        ret = retention(q.astype(jnp.float32), k.astype(jnp.float32), v.astype(jnp.float32))
        ret = ret * lax.rsqrt(jnp.mean(ret * ret, axis=-1, keepdims=True) + NORM_EPS)
        ret = ret.reshape(b, s, RET_V).astype(proj.dtype) * jax.nn.silu(g_ret)

        pool_out = multiscale_pool(p, pool_w[l], pool_scale[l])

        gate = jax.nn.sigmoid(gates.reshape(b, s, N_BRANCH, D_MODEL) + gate_bias[l])
        merged = gate[:, :, 0] * (ret @ w_ret_up[l]) + gate[:, :, 1] * (pool_out @ w_pool_up[l])
        h = h + merged @ w_out[l]

        h = h + FFN_RES_WEIGHT * swiglu_ffn(rmsnorm(h, norm_ffn2[l]), ffn2_w_in[l], ffn2_w_out[l])
    return rmsnorm(h, norm_final)
```

```cpp
#include <hip/hip_runtime.h>
#include <hip/hip_cooperative_groups.h>
#include <cstdio>
namespace cg = cooperative_groups;

#ifndef N_LAUNCH_MODE
#define N_LAUNCH_MODE 1
#endif

#define LAS __attribute__((address_space(3)))
typedef unsigned short bf16_t;
typedef short bf16x8 __attribute__((ext_vector_type(8)));
typedef short s16x4 __attribute__((ext_vector_type(4)));
typedef float f32x4 __attribute__((ext_vector_type(4)));
typedef unsigned u32x4 __attribute__((ext_vector_type(4)));
typedef unsigned u32x2 __attribute__((ext_vector_type(2)));

constexpr int MTOK = 32768, DM = 1024, DFF = 2816, SEQ = 4096, NIN = 7168;
constexpr float EPS = 1e-6f;

constexpr size_t MiB = 1024ull * 1024ull;
constexpr size_t WS_W1A = 0;
constexpr size_t WS_W1B = WS_W1A + 5632ull * 1024 * 2;
constexpr size_t WS_WIN = WS_W1B + 1024ull * 2816 * 2;
constexpr size_t WS_WPL = WS_WIN + 7168ull * 1024 * 2;
constexpr size_t WS_WRU = WS_WPL + 1024ull * 256 * 2;
constexpr size_t WS_WPU = WS_WRU + 1024ull * 1024 * 2;
constexpr size_t WS_WO  = WS_WPU + 1024ull * 1024 * 2;
constexpr size_t WS_W2A = WS_WO + 1024ull * 1024 * 2;
constexpr size_t WS_W2B = WS_W2A + 5632ull * 1024 * 2;
constexpr size_t WS_COS = WS_W2B + 1024ull * 2816 * 2;
constexpr size_t WS_SIN = WS_COS + 4096ull * 128 * 4;
constexpr size_t WS_SS1 = WS_SIN + 4096ull * 128 * 4;
constexpr size_t WS_SS2 = WS_SS1 + MTOK * 4ull;
constexpr size_t WS_SS3 = WS_SS2 + MTOK * 4ull;
constexpr size_t WS_SS4 = WS_SS3 + MTOK * 4ull;
constexpr size_t WS_SSR = WS_SS4 + MTOK * 4ull;
constexpr size_t WS_SMALL_END = WS_SSR + MTOK * 16ull;
static_assert(WS_SMALL_END <= 64 * MiB, "weights region");
constexpr size_t WS_S0 = 64 * MiB;
constexpr size_t WS_S1 = 128 * MiB;
constexpr size_t WS_BIG = 192 * MiB;
constexpr size_t WS_END = 512 * MiB;
constexpr size_t SLOT = 64 * MiB;

namespace pg8 {
constexpr int BM = 256, BK = 64, HALF = 128, HTB = HALF * BK * 2, STAGE_BYTES = 8 * HTB, NXCD = 8, WGM = 8;
__host__ __device__ __forceinline__ int lds_byte(int r, int c) { const int st = (r >> 4) * 2 + (c >> 5), rr = r & 15, cc = c & 31, ob = rr * 64 + cc * 2; return st * 1024 + (ob ^ (((ob >> 9) & 1) << 5)); }
__host__ __device__ __forceinline__ void stage_rc(int b, int& R, int& C) { const int st = b / 1024, sb = b % 1024, swz = sb ^ (((sb >> 9) & 1) << 5); R = (st >> 1) * 16 + swz / 64; C = (st & 1) * 32 + (swz % 64) / 2; }
__host__ __device__ __forceinline__ int perm32(int rho) { const int n = rho >> 4, i = rho & 15; return 8 * (i >> 2) + 4 * n + (i & 3); }

struct Unit { int pm, pn, pass; };
struct Gemm { const bf16_t* A; const bf16_t* Bt; int lda, ldb, K; int a_pn_off; };

struct StaticOrder {
    int nM, nN, nwg, G, c, rept;
    __host__ __device__ void init(int M, int N, int G_, int c_, int rept_ = 1) { nM = M / BM; nN = N / BM; nwg = nM * nN; G = G_; c = c_; rept = rept_; }
    __host__ __device__ bool next(int i, Unit& u) const {
        u.pass = 0;
        if (rept > 1) { const int ni = (nwg - c + G - 1) / G; if (ni <= 0 || i >= ni * rept) return false; u.pass = rept - 1 - i / ni; i = i % ni; }
        const long L = (long)i * G + c; if (L >= nwg) return false;
        int wgid = (int)L; { const int q = nwg / NXCD, r = nwg % NXCD, xcd = wgid % NXCD, off = wgid / NXCD; wgid = (xcd < r ? xcd * (q + 1) : r * (q + 1) + (xcd - r) * q) + off; }
        const int nig = WGM * nN, gid = wgid / nig, fm = gid * WGM, gsz = (nM - fm) < WGM ? (nM - fm) : WGM;
        u.pm = fm + ((wgid % nig) % gsz); u.pn = (wgid % nig) / gsz; return true;
    }
};
typedef float f32x2_t __attribute__((ext_vector_type(2)));
typedef __bf16 bf16x2_t __attribute__((ext_vector_type(2)));
__device__ __forceinline__ unsigned cvt_pk_bf16(float lo, float hi) { f32x2_t v = {lo, hi}; bf16x2_t b = __builtin_convertvector(v, bf16x2_t); return __builtin_bit_cast(unsigned, b); }

template <class Epi>
__device__ __forceinline__ void gemm_phase(LAS unsigned char* lds, const Gemm g, const StaticOrder& S, const Epi& E) {
    const int tid = threadIdx.x, wid = __builtin_amdgcn_readfirstlane(tid >> 6), lane = tid & 63, wr = wid >> 2, wc = wid & 3, fr = lane & 15, fq = lane >> 4;
    const int K = g.K, nt = K / BK;
    unsigned voffA[2], voffB[2];
#pragma unroll
    for (int i = 0; i < 2; ++i) { int R, C; stage_rc(tid * 16 + i * 8192, R, C); const int Rb = Epi::PERM ? ((R & ~31) + perm32(R & 31)) : R;
        voffA[i] = (unsigned)(R * g.lda + C) * 2u; voffB[i] = (unsigned)(Rb * g.ldb + C) * 2u; }
    const size_t kstep = (size_t)(BK * 2);
    const size_t hstepA = (size_t)HALF * g.lda * 2, hstepB = (size_t)HALF * g.ldb * 2;
    const size_t tstepA = 2 * hstepA, tstepB = 2 * hstepB;
    const unsigned ldsw = (unsigned)wid * 1024u;
    const int aoff = lds_byte(wr * 64 + fr, fq * 8), boff = lds_byte(wc * 32 + fr, fq * 8);
#define PG8_SA(b, h) (((b) * 2 + (h)) * HTB)
#define PG8_SB(b, h) ((4 + (b) * 2 + (h)) * HTB)
#define PG8_STAGE(bufoff, gbase, voff) do { _Pragma("unroll") for (int _i = 0; _i < 2; ++_i) \
        __builtin_amdgcn_global_load_lds((const unsigned*)((const char*)(gbase) + (voff)[_i]), (LAS unsigned*)(lds + (bufoff) + ldsw + _i * 8192), 16, 0, 0); } while (0)
#define PG8_LDA(dst, b, h) do { _Pragma("unroll") for (int m = 0; m < 4; ++m) _Pragma("unroll") for (int k = 0; k < 2; ++k) dst[m][k] = *(const LAS bf16x8*)(lds + PG8_SA(b, h) + aoff + m * 2048 + k * 1024); } while (0)
#define PG8_LDB(dst, b, h) do { _Pragma("unroll") for (int n = 0; n < 2; ++n) _Pragma("unroll") for (int k = 0; k < 2; ++k) dst[n][k] = *(const LAS bf16x8*)(lds + PG8_SB(b, h) + boff + n * 2048 + k * 1024); } while (0)
#define PG8_MMA(ai, bj, At, Bt) do { __builtin_amdgcn_s_setprio(1); _Pragma("unroll") for (int m = 0; m < 4; ++m) _Pragma("unroll") for (int n = 0; n < 2; ++n) _Pragma("unroll") for (int k = 0; k < 2; ++k) \
        acc[ai][bj][m][n] = __builtin_amdgcn_mfma_f32_16x16x32_bf16(Bt[n][k], At[m][k], acc[ai][bj][m][n], 0, 0, 0); __builtin_amdgcn_s_setprio(0); } while (0)
#define PG8_WAIT_V(n) asm volatile("s_waitcnt vmcnt(" #n ")" ::: "memory")
#define PG8_WAIT_L(n) asm volatile("s_waitcnt lgkmcnt(" #n ")" ::: "memory")
#define PG8_BAR __builtin_amdgcn_s_barrier()
#define PG8_SCHED __builtin_amdgcn_sched_barrier(0)
    Unit cur, nxt; int ui = 0;
    if (!S.next(0, cur)) return;
    typename Epi::Pre pre;
    f32x4 acc[2][2][4][2];
#pragma unroll
    for (int a = 0; a < 2; ++a)
#pragma unroll
        for (int b = 0; b < 2; ++b)
#pragma unroll
            for (int m = 0; m < 4; ++m)
#pragma unroll
                for (int n = 0; n < 2; ++n) acc[a][b][m][n] = (f32x4){0.f, 0.f, 0.f, 0.f};
    bf16x8 At[4][2], B0[2][2], B1[2][2];
    const char* cA = (const char*)g.A + (size_t)cur.pm * tstepA + (size_t)cur.pn * g.a_pn_off * 2; const char* cB = (const char*)g.Bt + (size_t)cur.pn * tstepB;
    PG8_STAGE(PG8_SB(0, 0), cB, voffB); PG8_STAGE(PG8_SA(0, 0), cA, voffA); PG8_STAGE(PG8_SB(0, 1), cB + hstepB, voffB); PG8_STAGE(PG8_SA(0, 1), cA + hstepA, voffA);
    if (wr == 1) PG8_BAR;
    PG8_WAIT_V(4); PG8_BAR;
    PG8_STAGE(PG8_SB(1, 0), cB + kstep, voffB); PG8_STAGE(PG8_SA(1, 0), cA + kstep, voffA); PG8_STAGE(PG8_SB(1, 1), cB + hstepB + kstep, voffB);
    PG8_WAIT_V(6); PG8_BAR;
    for (;;) {
        const bool has_next = S.next(ui + 1, nxt);
        const char* nA = has_next ? (const char*)g.A + (size_t)nxt.pm * tstepA + (size_t)nxt.pn * g.a_pn_off * 2 : cA; const char* nB = has_next ? (const char*)g.Bt + (size_t)nxt.pn * tstepB : cB;
#pragma unroll 1
        for (int t = 0; t < nt; t += 2) {
            const bool last = (t == nt - 2);
            const char* a1 = cA + (size_t)(t + 1) * kstep;
            const char* a2 = last ? nA : cA + (size_t)(t + 2) * kstep; const char* b2 = last ? nB : cB + (size_t)(t + 2) * kstep;
            const char* a3 = a2 + kstep; const char* b3 = b2 + kstep;
            if (last) E.prefetch(pre, cur, wr, wc, fr, fq);
            PG8_LDB(B0, 0, 0); PG8_SCHED; PG8_LDA(At, 0, 0); PG8_STAGE(PG8_SA(1, 1), a1 + hstepA, voffA);
            PG8_WAIT_L(8); PG8_BAR; PG8_WAIT_L(0); PG8_MMA(0, 0, At, B0); PG8_BAR; PG8_SCHED;
            PG8_LDB(B1, 0, 1); PG8_STAGE(PG8_SB(0, 0), b2, voffB);
            PG8_BAR; PG8_WAIT_L(0); PG8_MMA(0, 1, At, B1); PG8_BAR;
            PG8_LDA(At, 0, 1); PG8_STAGE(PG8_SA(0, 0), a2, voffA);
            PG8_BAR; PG8_WAIT_L(0); PG8_MMA(1, 0, At, B0); PG8_BAR; PG8_SCHED;
            PG8_STAGE(PG8_SB(0, 1), b2 + hstepB, voffB);
            PG8_WAIT_V(6); PG8_BAR; PG8_MMA(1, 1, At, B1); PG8_BAR;
            PG8_LDB(B0, 1, 0); PG8_SCHED; PG8_LDA(At, 1, 0); PG8_STAGE(PG8_SA(0, 1), a2 + hstepA, voffA);
            PG8_WAIT_L(8); PG8_BAR; PG8_WAIT_L(0); PG8_MMA(0, 0, At, B0); PG8_BAR; PG8_SCHED;
            PG8_LDB(B1, 1, 1); PG8_STAGE(PG8_SB(1, 0), b3, voffB);
            PG8_BAR; PG8_WAIT_L(0); PG8_MMA(0, 1, At, B1); PG8_BAR;
            PG8_LDA(At, 1, 1); PG8_STAGE(PG8_SA(1, 0), a3, voffA);
            PG8_BAR; PG8_WAIT_L(0); PG8_MMA(1, 0, At, B0); PG8_BAR; PG8_SCHED;
            PG8_STAGE(PG8_SB(1, 1), b3 + hstepB, voffB);
            PG8_WAIT_V(6); PG8_BAR; PG8_MMA(1, 1, At, B1); PG8_BAR;
        }
        if (wr == 0) PG8_BAR;
        E(acc, pre, cur, wr, wc, fr, fq);
        if (wr == 1) PG8_BAR;
        if (!has_next) break;
#pragma unroll
        for (int a = 0; a < 2; ++a)
#pragma unroll
            for (int b = 0; b < 2; ++b)
#pragma unroll
                for (int m = 0; m < 4; ++m)
#pragma unroll
                    for (int n = 0; n < 2; ++n) acc[a][b][m][n] = (f32x4){0.f, 0.f, 0.f, 0.f};
        cur = nxt; cA = nA; cB = nB; ++ui;
    }
    PG8_WAIT_V(0);
    if (wr == 0) PG8_BAR;
    PG8_BAR;
#undef PG8_SA
#undef PG8_SB
#undef PG8_STAGE
#undef PG8_LDA
#undef PG8_LDB
#undef PG8_MMA
#undef PG8_WAIT_V
#undef PG8_WAIT_L
#undef PG8_BAR
#undef PG8_SCHED
}
}
using pg8::cvt_pk_bf16;
using pg8::Unit;

__device__ __forceinline__ float sigm_f(float g) { return __builtin_amdgcn_rcpf(1.0f + __builtin_amdgcn_exp2f(g * -1.4426950408889634f)); }
__device__ __forceinline__ float silu_f(float g) { return g * sigm_f(g); }
__device__ __forceinline__ f32x4 sigm4(const f32x4 g) { const f32x4 a = g * -1.4426950408889634f; f32x4 e; e[0] = __builtin_amdgcn_exp2f(a[0]); e[1] = __builtin_amdgcn_exp2f(a[1]); e[2] = __builtin_amdgcn_exp2f(a[2]); e[3] = __builtin_amdgcn_exp2f(a[3]);
    const f32x4 d = e + 1.0f; f32x4 r; r[0] = __builtin_amdgcn_rcpf(d[0]); r[1] = __builtin_amdgcn_rcpf(d[1]); r[2] = __builtin_amdgcn_rcpf(d[2]); r[3] = __builtin_amdgcn_rcpf(d[3]); return r; }
__device__ __forceinline__ float rs_of(float ss) { return __builtin_amdgcn_rsqf(ss * (1.0f / 1024.0f) + EPS); }
__device__ __forceinline__ float bf2f(unsigned short b) { return __uint_as_float(((unsigned)b) << 16); }
__device__ __forceinline__ u32x4 pack8(const f32x4 a, const f32x4 b) { u32x4 w; w.x = cvt_pk_bf16(a[0], a[1]); w.y = cvt_pk_bf16(a[2], a[3]); w.z = cvt_pk_bf16(b[0], b[1]); w.w = cvt_pk_bf16(b[2], b[3]); return w; }
__device__ __forceinline__ void unpack8(const u32x4 w, f32x4& a, f32x4& b) {
    a[0] = __uint_as_float(w.x << 16); a[1] = __uint_as_float(w.x & 0xffff0000u); a[2] = __uint_as_float(w.y << 16); a[3] = __uint_as_float(w.y & 0xffff0000u);
    b[0] = __uint_as_float(w.z << 16); b[1] = __uint_as_float(w.z & 0xffff0000u); b[2] = __uint_as_float(w.w << 16); b[3] = __uint_as_float(w.w & 0xffff0000u); }

#define ROWOF(ri) (row0 + ((ri) >> 2) * 128 + ((ri) & 3) * 16)
#define ACC(ri, bj, n) acc[(ri) >> 2][bj][(ri) & 3][n]
struct EpiSwiglu {
    static constexpr bool PERM = true;
    struct Pre {};
    __device__ __forceinline__ void prefetch(Pre&, const Unit&, int, int, int, int) const {}
    bf16_t* O; const float* ss;
    __device__ __forceinline__ void operator()(const f32x4 (&acc)[2][2][4][2], Pre& pre, const Unit& u, int wr, int wc, int fr, int fq) const {
        const int row0 = u.pm * 256 + wr * 64 + fr, col0 = u.pn * 128 + wc * 32 + 8 * fq;
        float ssv[8];
#pragma unroll
        for (int ri = 0; ri < 8; ++ri) ssv[ri] = ss[ROWOF(ri)];
#pragma unroll
        for (int ri = 0; ri < 8; ++ri) { const int r = ROWOF(ri); const float rs = rs_of(ssv[ri]);
            f32x4 o[2];
#pragma unroll
            for (int n = 0; n < 2; ++n) { const f32x4 gt = ACC(ri, 0, n) * rs, up = ACC(ri, 1, n) * rs; o[n] = (gt * up) * sigm4(gt); }
            *(u32x4*)(O + (size_t)r * DFF + col0) = pack8(o[0], o[1]); }
    }
};
template <bool IN_F32> struct EpiResid {
    static constexpr bool PERM = true;
    struct Pre {};
    __device__ __forceinline__ void prefetch(Pre&, const Unit&, int, int, int, int) const {}
    const void* hin; bf16_t* hb_; float* ss_; float scale; bf16_t* hb_d; float* ss_d;
    __device__ __forceinline__ void ldrow(size_t off, f32x4 (&b)[2][2]) const {
#pragma unroll
        for (int bj = 0; bj < 2; ++bj) {
            if (IN_F32) { b[bj][0] = *(const f32x4*)((const float*)hin + off + bj * 128); b[bj][1] = *(const f32x4*)((const float*)hin + off + bj * 128 + 4); }
            else unpack8(*(const u32x4*)((const bf16_t*)hin + off + bj * 128), b[bj][0], b[bj][1]); }
    }
    __device__ __forceinline__ void operator()(const f32x4 (&acc)[2][2][4][2], Pre& pre, const Unit& u, int wr, int wc, int fr, int fq) const {
        bf16_t* hb = hb_; float* ss = ss_;
        if (u.pass > 0) { hb = hb_d; ss = ss_d; }
        const int row0 = u.pm * 256 + wr * 64 + fr, col0 = u.pn * 256 + wc * 32 + 8 * fq;
        f32x4 bb[2][2][2];
        ldrow((size_t)ROWOF(0) * DM + col0, bb[0]);
#pragma unroll
        for (int ri = 0; ri < 8; ++ri) { const int r = ROWOF(ri); const size_t off = (size_t)r * DM + col0; float q = 0.f;
            if (ri < 7) ldrow((size_t)ROWOF(ri + 1) * DM + col0, bb[(ri + 1) & 1]);
#pragma unroll
            for (int bj = 0; bj < 2; ++bj) {
                const f32x4 o0 = bb[ri & 1][bj][0] + ACC(ri, bj, 0) * scale, o1 = bb[ri & 1][bj][1] + ACC(ri, bj, 1) * scale;
                *(u32x4*)(hb + off + bj * 128) = pack8(o0, o1);
                q += ((o0[0] * o0[0] + o0[1] * o0[1]) + (o0[2] * o0[2] + o0[3] * o0[3])) + ((o1[0] * o1[0] + o1[1] * o1[1]) + (o1[2] * o1[2] + o1[3] * o1[3])); }
            q += __shfl_xor(q, 16); q += __shfl_xor(q, 32);
            if (fq == 0) atomicAdd(ss + r, q); }
    }
};
struct EpiQKV {
    static constexpr bool PERM = true;
    struct Pre {};
    __device__ __forceinline__ void prefetch(Pre&, const Unit&, int, int, int, int) const {}
    bf16_t* QKV; const float* ss; const float* cosT; const float* sinT;
    __device__ __forceinline__ void operator()(const f32x4 (&acc)[2][2][4][2], Pre& pre, const Unit& u, int wr, int wc, int fr, int fq) const {
        const int sect = u.pn >> 2, hd = u.pn & 3; bf16_t* base = QKV + (size_t)sect * (SLOT / 2);
        const int row0 = u.pm * 256 + wr * 64 + fr, j0 = wc * 32 + 8 * fq; const float ksc = sect == 1 ? 0.0625f : 1.0f;
        float ssv[8];
#pragma unroll
        for (int ri = 0; ri < 8; ++ri) ssv[ri] = ss[ROWOF(ri)];
        f32x4 cs[2][2][2];
#pragma unroll
        for (int n = 0; n < 2; ++n) { cs[0][0][n] = (f32x4){1.f, 1.f, 1.f, 1.f}; cs[0][1][n] = (f32x4){0.f, 0.f, 0.f, 0.f}; cs[1][0][n] = cs[0][0][n]; cs[1][1][n] = cs[0][1][n]; }
        if (sect < 2) { const int pos = ROWOF(0) & (SEQ - 1);
#pragma unroll
            for (int n = 0; n < 2; ++n) { cs[0][0][n] = *(const f32x4*)(cosT + pos * 128 + j0 + 4 * n); cs[0][1][n] = *(const f32x4*)(sinT + pos * 128 + j0 + 4 * n); } }
#pragma unroll
        for (int ri = 0; ri < 8; ++ri) { const int r = ROWOF(ri); const float rs = rs_of(ssv[ri]);
            if (ri < 7 && sect < 2) { const int pos = ROWOF(ri + 1) & (SEQ - 1);
#pragma unroll
                for (int n = 0; n < 2; ++n) { cs[(ri + 1) & 1][0][n] = *(const f32x4*)(cosT + pos * 128 + j0 + 4 * n); cs[(ri + 1) & 1][1][n] = *(const f32x4*)(sinT + pos * 128 + j0 + 4 * n); } }
            f32x4 o1[2], o2[2];
#pragma unroll
            for (int n = 0; n < 2; ++n) { const f32x4 c = cs[ri & 1][0][n], sn = cs[ri & 1][1][n];
                const f32x4 x1 = ACC(ri, 0, n) * rs, x2 = ACC(ri, 1, n) * rs; o1[n] = (x1 * c - x2 * sn) * ksc; o2[n] = (x1 * sn + x2 * c) * ksc; }
            bf16_t* rp = base + (size_t)r * DM + hd * 256 + j0;
            *(u32x4*)(rp) = pack8(o1[0], o1[1]); *(u32x4*)(rp + 128) = pack8(o2[0], o2[1]); }
    }
};
struct EpiGates {
    static constexpr bool PERM = true;
    struct Pre {};
    __device__ __forceinline__ void prefetch(Pre&, const Unit&, int, int, int, int) const {}
    unsigned char* wsb; bf16_t* ohi; const float* ss; const float* gbias;
    __device__ __forceinline__ void operator()(const f32x4 (&acc)[2][2][4][2], Pre& pre, const Unit& u, int wr, int wc, int fr, int fq) const {
        const int sect = u.pn >> 2, ct = (u.pn & 3) * 256; bf16_t* O = sect == 3 ? ohi : (bf16_t*)(wsb + (size_t)((0x726u >> (4 * sect)) & 0xFu) * SLOT);
        const int row0 = u.pm * 256 + wr * 64 + fr, c0 = ct + wc * 32 + 8 * fq;
        float ssv[8];
#pragma unroll
        for (int ri = 0; ri < 8; ++ri) ssv[ri] = ss[ROWOF(ri)];
        f32x4 bv[2][2];
#pragma unroll
        for (int bj = 0; bj < 2; ++bj)
#pragma unroll
            for (int n = 0; n < 2; ++n) bv[bj][n] = sect >= 2 ? *(const f32x4*)(gbias + (sect - 2) * DM + c0 + bj * 128 + 4 * n) : (f32x4){0.f, 0.f, 0.f, 0.f};
#pragma unroll
        for (int ri = 0; ri < 8; ++ri) { const int r = ROWOF(ri); const float rs = rs_of(ssv[ri]);
#pragma unroll
            for (int bj = 0; bj < 2; ++bj) { f32x4 o[2];
#pragma unroll
                for (int n = 0; n < 2; ++n) { const f32x4 v = ACC(ri, bj, n) * rs + bv[bj][n]; o[n] = v; if (sect != 1) { const f32x4 sg = sigm4(v); o[n] = sect == 0 ? v * sg : sg; } }
                *(u32x4*)(O + (size_t)r * DM + c0 + bj * 128) = pack8(o[0], o[1]); } }
    }
};
struct EpiScaleCol {
    static constexpr bool PERM = true;
    struct Pre {};
    __device__ __forceinline__ void prefetch(Pre&, const Unit&, int, int, int, int) const {}
    bf16_t* O; const float* scale;
    __device__ __forceinline__ void operator()(const f32x4 (&acc)[2][2][4][2], Pre& pre, const Unit& u, int wr, int wc, int fr, int fq) const {
        const int row0 = u.pm * 256 + wr * 64 + fr, c0 = u.pn * 256 + wc * 32 + 8 * fq;
        f32x4 sv[2][2];
#pragma unroll
        for (int bj = 0; bj < 2; ++bj)
#pragma unroll
            for (int n = 0; n < 2; ++n) sv[bj][n] = *(const f32x4*)(scale + c0 + bj * 128 + 4 * n);
#pragma unroll
        for (int ri = 0; ri < 8; ++ri) { const int r = ROWOF(ri);
#pragma unroll
            for (int bj = 0; bj < 2; ++bj) *(u32x4*)(O + (size_t)r * DM + c0 + bj * 128) = pack8(ACC(ri, bj, 0) * sv[bj][0], ACC(ri, bj, 1) * sv[bj][1]); }
    }
};
template <bool ADD> struct EpiGateMul {
    static constexpr bool PERM = true;
    struct Pre {};
    __device__ __forceinline__ void prefetch(Pre&, const Unit&, int, int, int, int) const {}
    bf16_t* O; const bf16_t* G; const bf16_t* Min;
    __device__ __forceinline__ void ldrow(size_t off, u32x4 (&g)[2], u32x4 (&a)[2]) const {
#pragma unroll
        for (int bj = 0; bj < 2; ++bj) { g[bj] = *(const u32x4*)(G + off + bj * 128); if (ADD) a[bj] = *(const u32x4*)(Min + off + bj * 128); }
    }
    __device__ __forceinline__ void operator()(const f32x4 (&acc)[2][2][4][2], Pre& pre, const Unit& u, int wr, int wc, int fr, int fq) const {
        const int row0 = u.pm * 256 + wr * 64 + fr, c0 = u.pn * 256 + wc * 32 + 8 * fq;
        u32x4 gb[2][2], ab[2][2];
        ldrow((size_t)ROWOF(0) * DM + c0, gb[0], ab[0]);
#pragma unroll
        for (int ri = 0; ri < 8; ++ri) { const size_t off = (size_t)ROWOF(ri) * DM + c0;
            if (ri < 7) ldrow((size_t)ROWOF(ri + 1) * DM + c0, gb[(ri + 1) & 1], ab[(ri + 1) & 1]);
#pragma unroll
            for (int bj = 0; bj < 2; ++bj) {
                f32x4 g0, g1; unpack8(gb[ri & 1][bj], g0, g1);
                f32x4 o0 = g0 * ACC(ri, bj, 0), o1 = g1 * ACC(ri, bj, 1);
                if (ADD) { f32x4 a0, a1; unpack8(ab[ri & 1][bj], a0, a1); o0 += a0; o1 += a1; }
                *(u32x4*)(O + off + bj * 128) = pack8(o0, o1); } }
    }
};

__device__ __forceinline__ unsigned pk2(float lo, float hi) { return cvt_pk_bf16(lo, hi); }
template <int MODE>
__device__ __forceinline__ void p0_transpose_item(const float* W, int ldw, bf16_t* WT, int ldt, int nblk, const float* gain, LAS float* scr, int item, int lane) {
    const int kb = item / nblk, nb = item % nblk, k0 = 64 * kb, n0 = 32 * nb;
    int sc0 = n0;
    if (MODE == 1) { const int tile = n0 >> 8, r = n0 & 255; sc0 = (r >> 7) * DFF + 128 * tile + (r & 127); }
    f32x4 v[8]; float gv[8];
#pragma unroll
    for (int i = 0; i < 8; ++i) { const int kk = 8 * i + (lane >> 3); v[i] = *(const f32x4*)(W + (size_t)(k0 + kk) * ldw + sc0 + (lane & 7) * 4); gv[i] = gain ? gain[k0 + kk] : 1.0f; }
#pragma unroll
    for (int i = 0; i < 8; ++i) { const int kk = 8 * i + (lane >> 3); LAS float* d = scr + kk * 33 + (lane & 7) * 4;
        d[0] = v[i][0] * gv[i]; d[1] = v[i][1] * gv[i]; d[2] = v[i][2] * gv[i]; d[3] = v[i][3] * gv[i]; }
    asm volatile("s_waitcnt lgkmcnt(0)" ::: "memory");
    const int c = lane & 7;
#pragma unroll
    for (int j = 0; j < 4; ++j) { const int n = (lane >> 3) + 8 * j; const LAS float* s = scr + (8 * c) * 33 + n;
        u32x4 o; o.x = pk2(s[0 * 33], s[1 * 33]); o.y = pk2(s[2 * 33], s[3 * 33]); o.z = pk2(s[4 * 33], s[5 * 33]); o.w = pk2(s[6 * 33], s[7 * 33]);
        *(u32x4*)(WT + (size_t)(n0 + n) * ldt + k0 + 8 * c) = o; }
    asm volatile("s_waitcnt lgkmcnt(0)" ::: "memory");
}

struct Params {
    const float* in[16];
    float* out; unsigned char* ws;
    int ph_lo, ph_hi;
};

__device__ __forceinline__ void p0_prologue(const Params& p, LAS unsigned char* lds) {
    const int tid = threadIdx.x, lane = tid & 63, wave = tid >> 6;
    const int G = gridDim.x, gw = blockIdx.x * 8 + wave, NGW = G * 8;
    unsigned char* ws = p.ws;
    LAS float* scr = (LAS float*)(lds + wave * 16384);
    constexpr int I_1A = 16 * 176, I_1B = 44 * 32, I_IN = 16 * 224, I_PL = 4 * 32, I_SQ = 16 * 32;
    constexpr int NITEMS = 2 * I_1A + 2 * I_1B + I_IN + I_PL + 3 * I_SQ;
    for (int it = gw; it < NITEMS; it += NGW) {
        int r = it;
        if (r < I_1A) { p0_transpose_item<1>(p.in[2], 2 * DFF, (bf16_t*)(ws + WS_W1A), DM, 176, p.in[1], scr, r, lane); continue; } r -= I_1A;
        if (r < I_1A) { p0_transpose_item<1>(p.in[13], 2 * DFF, (bf16_t*)(ws + WS_W2A), DM, 176, p.in[12], scr, r, lane); continue; } r -= I_1A;
        if (r < I_1B) { p0_transpose_item<0>(p.in[3], DM, (bf16_t*)(ws + WS_W1B), DFF, 32, nullptr, scr, r, lane); continue; } r -= I_1B;
        if (r < I_1B) { p0_transpose_item<0>(p.in[14], DM, (bf16_t*)(ws + WS_W2B), DFF, 32, nullptr, scr, r, lane); continue; } r -= I_1B;
        if (r < I_IN) { p0_transpose_item<0>(p.in[5], NIN, (bf16_t*)(ws + WS_WIN), DM, 224, p.in[4], scr, r, lane); continue; } r -= I_IN;
        if (r < I_PL) { const int g = r >> 5; p0_transpose_item<0>(p.in[7] + (size_t)g * 65536, 256, (bf16_t*)(ws + WS_WPL) + (size_t)g * 65536, 256, 8, nullptr, scr, r & 31, lane); continue; } r -= I_PL;
        if (r < I_SQ) { p0_transpose_item<0>(p.in[9], DM, (bf16_t*)(ws + WS_WRU), DM, 32, nullptr, scr, r, lane); continue; } r -= I_SQ;
        if (r < I_SQ) { p0_transpose_item<0>(p.in[10], DM, (bf16_t*)(ws + WS_WPU), DM, 32, nullptr, scr, r, lane); continue; } r -= I_SQ;
        p0_transpose_item<0>(p.in[11], DM, (bf16_t*)(ws + WS_WO), DM, 32, nullptr, scr, r, lane);
    }
    const float* x = p.in[0]; bf16_t* XB = (bf16_t*)(ws + WS_S0); float* ss1 = (float*)(ws + WS_SS1);
    {
        f32x4 vn[4];
        if (gw < MTOK) { const f32x4* xr = (const f32x4*)(x + (size_t)gw * DM) + lane;
#pragma unroll
            for (int j = 0; j < 4; ++j) vn[j] = xr[64 * j]; }
        for (int m = gw; m < MTOK; m += NGW) {
            f32x4 v[4]; float s = 0.f;
#pragma unroll
            for (int j = 0; j < 4; ++j) v[j] = vn[j];
            if (m + NGW < MTOK) { const f32x4* xr = (const f32x4*)(x + (size_t)(m + NGW) * DM) + lane;
#pragma unroll
                for (int j = 0; j < 4; ++j) vn[j] = xr[64 * j]; }
#pragma unroll
            for (int j = 0; j < 4; ++j) s += (v[j][0] * v[j][0] + v[j][1] * v[j][1]) + (v[j][2] * v[j][2] + v[j][3] * v[j][3]);
#pragma unroll
            for (int o = 1; o < 64; o <<= 1) s += __shfl_xor(s, o);
            u32x2* o8 = (u32x2*)(XB + (size_t)m * DM) + lane;
#pragma unroll
            for (int j = 0; j < 4; ++j) { u32x2 w; w.x = pk2(v[j][0], v[j][1]); w.y = pk2(v[j][2], v[j][3]); o8[64 * j] = w; }
            if (lane == 0) ss1[m] = s;
        }
    }
    const int gt = blockIdx.x * 512 + tid, NGT = G * 512;
    float* cosT = (float*)(ws + WS_COS); float* sinT = (float*)(ws + WS_SIN);
    for (int i = gt; i < SEQ * 128; i += NGT) { const int pos = i >> 7, j = i & 127;
        const float inv = exp2f(-(float)j * (13.287712379549449f / 128.0f)); const float ang = (float)pos * inv;
        const double rev = (double)ang * 0.15915494309189533577; const float fr_ = (float)(rev - rint(rev));
        cosT[i] = __builtin_amdgcn_cosf(fr_); sinT[i] = __builtin_amdgcn_sinf(fr_); }
    float* z = (float*)(ws + WS_SS2);
    for (int i = gt; i < MTOK * 3 + MTOK * 4; i += NGT) z[i] = 0.f;
}

template <int O0, int O1, int O2, int O3>
__device__ __forceinline__ void tr4(unsigned addr, s16x4& a, s16x4& b, s16x4& c, s16x4& d) {
    asm volatile("ds_read_b64_tr_b16 %0, %4 offset:%5\n\tds_read_b64_tr_b16 %1, %4 offset:%6\n\tds_read_b64_tr_b16 %2, %4 offset:%7\n\tds_read_b64_tr_b16 %3, %4 offset:%8"
                 : "=&v"(a), "=&v"(b), "=&v"(c), "=&v"(d) : "v"(addr), "i"(O0), "i"(O1), "i"(O2), "i"(O3) : "memory");
}
__device__ __forceinline__ void tr_wait4(s16x4& a, s16x4& b, s16x4& c, s16x4& d) { asm volatile("s_waitcnt lgkmcnt(0)" : "+v"(a), "+v"(b), "+v"(c), "+v"(d) :: "memory"); }
__device__ __forceinline__ bf16x8 cat8(const s16x4 a, const s16x4 b) { bf16x8 r; r[0] = a[0]; r[1] = a[1]; r[2] = a[2]; r[3] = a[3]; r[4] = b[0]; r[5] = b[1]; r[6] = b[2]; r[7] = b[3]; return r; }
__device__ __forceinline__ unsigned short f2bf(float f) { unsigned u = __float_as_uint(f); u += 0x7fffu + ((u >> 16) & 1u); return (unsigned short)(u >> 16); }
__device__ __forceinline__ unsigned pk2s(float lo, float hi) { return pg8::cvt_pk_bf16(lo, hi); }

__device__ __forceinline__ void retention_phase(LAS unsigned char* lds, const bf16_t* Q, const bf16_t* Kb, const bf16_t* V, bf16_t* RET, float* ssr) {
    const int tid = threadIdx.x, wid = __builtin_amdgcn_readfirstlane(tid >> 6), lane = tid & 63, fr = lane & 15, fq = lane >> 4;
    constexpr int QP = 528, VP = 80, PP = 144;
    constexpr int OFF_Q = 0, OFF_K = 33792, OFF_V = 67584, OFF_VD = 72704, OFF_P = 77824, OFF_ST = 87040, ST_BYTES = 16896;
    const unsigned lbase = (unsigned)(size_t)lds;
    const int trq = fr >> 2, trp = fr & 3;
    for (int item = blockIdx.x; item < 256; item += gridDim.x) {
        const int xcd = item & 7, loc = item >> 3, bh = xcd * 4 + (loc >> 3), js = loc & 7, b = bh >> 2, h = bh & 3;
        const float lg = log2f(1.0f - exp2f(-5.0f - (float)h));
        const float cdec = __builtin_amdgcn_exp2f(lg * 64.0f);
        __syncthreads();
        for (int i = tid; i < ST_BYTES / 4; i += 512) ((LAS unsigned*)(lds + OFF_ST))[i] = 0u;
        f32x4 sacc[2][2];
#pragma unroll
        for (int a = 0; a < 2; ++a)
#pragma unroll
            for (int c = 0; c < 2; ++c) sacc[a][c] = (f32x4){0.f, 0.f, 0.f, 0.f};
        const size_t tok0 = (size_t)b * SEQ;
        u32x4 rq[4], rk[4], rv;
#define RET_LOAD(c) do { _Pragma("unroll") for (int _i = 0; _i < 4; ++_i) { const int pc = tid + 512 * _i, row = pc >> 5, ch = pc & 31; const size_t e = (tok0 + 64 * (c) + row) * DM + h * 256 + ch * 8; \
            rq[_i] = *(const u32x4*)(Q + e); rk[_i] = *(const u32x4*)(Kb + e); } \
            if (tid < 256) { const int row = tid >> 2, ch = tid & 3; rv = *(const u32x4*)(V + (tok0 + 64 * (c) + row) * DM + h * 256 + js * 32 + ch * 8); } } while (0)
        RET_LOAD(0);
        for (int c = 0; c < 64; ++c) {
            __syncthreads();
#pragma unroll
            for (int i = 0; i < 4; ++i) { const int pc = tid + 512 * i, row = pc >> 5, ch = pc & 31;
                *(LAS u32x4*)(lds + OFF_Q + row * QP + ch * 16) = rq[i]; *(LAS u32x4*)(lds + OFF_K + row * QP + ch * 16) = rk[i]; }
            if (tid < 256) { const int row = tid >> 2, ch = tid & 3; *(LAS u32x4*)(lds + OFF_V + row * VP + ch * 16) = rv;
                const float kd = __builtin_amdgcn_exp2f(lg * (float)(63 - row)); f32x4 a0, a1; unpack8(rv, a0, a1); a0 *= kd; a1 *= kd;
                u32x4 w; w.x = pk2s(a0[0], a0[1]); w.y = pk2s(a0[2], a0[3]); w.z = pk2s(a1[0], a1[1]); w.w = pk2s(a1[2], a1[3]);
                *(LAS u32x4*)(lds + OFF_VD + row * VP + ch * 16) = w; }
            if (c + 1 < 64) RET_LOAD(c + 1);
            __syncthreads();
            bf16x8 qfc[8];
            {
                const int r = wid >> 1, kb0 = 2 * (wid & 1);
                f32x4 sT[2] = {(f32x4){0.f, 0.f, 0.f, 0.f}, (f32x4){0.f, 0.f, 0.f, 0.f}};
#pragma unroll
                for (int ks = 0; ks < 8; ++ks) {
                    const bf16x8 qf = *(const LAS bf16x8*)(lds + OFF_Q + (16 * r + fr) * QP + (32 * ks + 8 * fq) * 2); qfc[ks] = qf;
#pragma unroll
                    for (int j = 0; j < 2; ++j) { const bf16x8 kf = *(const LAS bf16x8*)(lds + OFF_K + (16 * (kb0 + j) + fr) * QP + (32 * ks + 8 * fq) * 2);
                        sT[j] = __builtin_amdgcn_mfma_f32_16x16x32_bf16(kf, qf, sT[j], 0, 0, 0); }
                }
                const int n = 16 * r + fr;
#pragma unroll
                for (int j = 0; j < 2; ++j) { const int m0 = 16 * (kb0 + j) + 4 * fq; float pv[4];
#pragma unroll
                    for (int i = 0; i < 4; ++i) { const int d = n - (m0 + i); pv[i] = sT[j][i] * __builtin_amdgcn_exp2f(lg * (float)(d < 0 ? -d : d)); }
                    u32x2 w; w.x = pk2s(pv[0], pv[1]); w.y = pk2s(pv[2], pv[3]);
                    *(LAS u32x2*)(lds + OFF_P + n * PP + m0 * 2) = w; }
            }
            {
#pragma unroll
                for (int a = 0; a < 2; ++a)
#pragma unroll
                    for (int cc = 0; cc < 2; ++cc) sacc[a][cc] *= cdec;
                {
                    const int r0 = 8 * fq + trq;
                    s16x4 ta[2][4], tb[2][4];
#pragma unroll
                    for (int a = 0; a < 2; ++a) tr4<0, 4 * QP, 32 * QP, 36 * QP>(lbase + OFF_K + r0 * QP + (16 * (2 * wid + a) + 4 * trp) * 2, ta[a][0], ta[a][1], ta[a][2], ta[a][3]);
#pragma unroll
                    for (int cc = 0; cc < 2; ++cc) tr4<0, 4 * VP, 32 * VP, 36 * VP>(lbase + OFF_VD + r0 * VP + (16 * cc + 4 * trp) * 2, tb[cc][0], tb[cc][1], tb[cc][2], tb[cc][3]);
                    tr_wait4(ta[0][0], ta[0][1], ta[0][2], ta[0][3]); tr_wait4(ta[1][0], ta[1][1], ta[1][2], ta[1][3]);
                    tr_wait4(tb[0][0], tb[0][1], tb[0][2], tb[0][3]); tr_wait4(tb[1][0], tb[1][1], tb[1][2], tb[1][3]);
#pragma unroll
                    for (int ks = 0; ks < 2; ++ks)
#pragma unroll
                        for (int a = 0; a < 2; ++a)
#pragma unroll
                            for (int cc = 0; cc < 2; ++cc) sacc[a][cc] = __builtin_amdgcn_mfma_f32_16x16x32_bf16(cat8(ta[a][2 * ks], ta[a][2 * ks + 1]), cat8(tb[cc][2 * ks], tb[cc][2 * ks + 1]), sacc[a][cc], 0, 0, 0);
                }
                LAS unsigned char* stn = lds + OFF_ST + ((c + 1) & 1) * ST_BYTES;
#pragma unroll
                for (int a = 0; a < 2; ++a)
#pragma unroll
                    for (int cc = 0; cc < 2; ++cc) { u32x2 w; w.x = pk2s(sacc[a][cc][0], sacc[a][cc][1]); w.y = pk2s(sacc[a][cc][2], sacc[a][cc][3]);
                        *(LAS u32x2*)(stn + (16 * cc + fr) * QP + (16 * (2 * wid + a) + 4 * fq) * 2) = w; }
            }
            __syncthreads();
            {
                const int r = wid >> 1, cb = wid & 1;
                f32x4 ain = (f32x4){0.f, 0.f, 0.f, 0.f}, acr = (f32x4){0.f, 0.f, 0.f, 0.f};
                {
                    s16x4 tv[4];
                    tr4<0, 4 * VP, 32 * VP, 36 * VP>(lbase + OFF_V + (8 * fq + trq) * VP + (16 * cb + 4 * trp) * 2, tv[0], tv[1], tv[2], tv[3]);
                    bf16x8 pf[2];
#pragma unroll
                    for (int ks = 0; ks < 2; ++ks) pf[ks] = *(const LAS bf16x8*)(lds + OFF_P + (16 * r + fr) * PP + (32 * ks + 8 * fq) * 2);
                    tr_wait4(tv[0], tv[1], tv[2], tv[3]);
#pragma unroll
                    for (int ks = 0; ks < 2; ++ks) ain = __builtin_amdgcn_mfma_f32_16x16x32_bf16(cat8(tv[2 * ks], tv[2 * ks + 1]), pf[ks], ain, 0, 0, 0);
                }
                const LAS unsigned char* stc = lds + OFF_ST + (c & 1) * ST_BYTES;
#pragma unroll
                for (int ks = 0; ks < 8; ++ks) {
                    const bf16x8 qf = qfc[ks];
                    const bf16x8 sf = *(const LAS bf16x8*)(stc + (16 * cb + fr) * QP + (32 * ks + 8 * fq) * 2);
                    acr = __builtin_amdgcn_mfma_f32_16x16x32_bf16(sf, qf, acr, 0, 0, 0);
                }
                const int n = 16 * r + fr; const float qd = __builtin_amdgcn_exp2f(lg * (float)(n + 1));
                const f32x4 o = ain + acr * qd;
                const size_t t = tok0 + 64 * c + n;
                u32x2 w; w.x = pk2s(o[0], o[1]); w.y = pk2s(o[2], o[3]);
                *(u32x2*)(RET + t * DM + h * 256 + js * 32 + cb * 16 + 4 * fq) = w;
                float q = (o[0] * o[0] + o[1] * o[1]) + (o[2] * o[2] + o[3] * o[3]);
                q += __shfl_xor(q, 16); q += __shfl_xor(q, 32);
                if (fq == 0) atomicAdd(ssr + t * 4 + h, q);
            }
        }
#undef RET_LOAD
    }
}

__device__ __forceinline__ void mix_elementwise(const bf16_t* RET, bf16_t* RN, const bf16_t* GR, const float* ssr, const bf16_t* P, bf16_t* PL) {
    const int gt = blockIdx.x * 512 + threadIdx.x, NGT = gridDim.x * 512;
    constexpr int T = 32;
    for (int item = gt; item < 128 * (MTOK / T); item += NGT) {
        const int ch = item & 127, g = ch >> 5, w = 2 << g; const size_t t0 = (size_t)(item >> 7) * T; const int pos0 = (int)(t0 & (SEQ - 1));
        const size_t base = t0 * DM + ch * 8;
        f32x4 s0 = (f32x4){0.f, 0.f, 0.f, 0.f}, s1 = s0;
        for (int k = 1; k < w; ++k) if (pos0 - k >= 0) { f32x4 b0, b1; unpack8(*(const u32x4*)(P + base - (size_t)k * DM), b0, b1); s0 += b0; s1 += b1; }
        u32x4 pc = *(const u32x4*)(P + base), rc = *(const u32x4*)(RET + base), gc = *(const u32x4*)(GR + base), oc = (u32x4){0u, 0u, 0u, 0u};
        float sq = ssr[t0 * 4 + g];
        if (pos0 + 1 >= w) oc = *(const u32x4*)(P + base - (size_t)(w - 1) * DM);
        for (int j = 0; j < T; ++j) {
            const size_t off = base + (size_t)j * DM; const int pos = pos0 + j;
            const u32x4 pcur = pc, rcur = rc, gcur = gc, ocur = oc; const float sqc = sq;
            if (j + 1 < T) { pc = *(const u32x4*)(P + off + DM); rc = *(const u32x4*)(RET + off + DM); gc = *(const u32x4*)(GR + off + DM); sq = ssr[(t0 + j + 1) * 4 + g];
                if (pos + 2 >= w) oc = *(const u32x4*)(P + off + DM - (size_t)(w - 1) * DM); }
            f32x4 c0, c1; unpack8(pcur, c0, c1); s0 += c0; s1 += c1;
            const int cnt = (pos + 1) < w ? (pos + 1) : w; const float inv = 1.0f / (float)cnt;
            *(u32x4*)(PL + off) = pack8(s0 * inv - c0, s1 * inv - c1);
            if (pos + 1 >= w) { f32x4 o0, o1; unpack8(ocur, o0, o1); s0 -= o0; s1 -= o1; }
            const float rs = __builtin_amdgcn_rsqf(sqc * (1.0f / 256.0f) + EPS);
            f32x4 a0, a1, g0, g1; unpack8(rcur, a0, a1); unpack8(gcur, g0, g1);
            *(u32x4*)(RN + off) = pack8(a0 * rs * g0, a1 * rs * g1);
        }
    }
}

__device__ __forceinline__ void final_norm(const bf16_t* hin, float* out, const float* ss, const float* g) {
    const size_t gt = (size_t)blockIdx.x * 512 + threadIdx.x, NGT = (size_t)gridDim.x * 512, NI = (size_t)MTOK * 128;
    u32x4 hn = (u32x4){0u, 0u, 0u, 0u}; float sn = 1.f;
    if (gt < NI) { hn = *(const u32x4*)(hin + (gt >> 7) * DM + (gt & 127) * 8); sn = ss[gt >> 7]; }
    for (size_t i = gt; i < NI; i += NGT) {
        const size_t t = i >> 7; const int c8 = (int)(i & 127) * 8; const u32x4 hc = hn; const float rs = rs_of(sn);
        const size_t i2 = i + NGT;
        if (i2 < NI) { hn = *(const u32x4*)(hin + (i2 >> 7) * DM + (i2 & 127) * 8); sn = ss[i2 >> 7]; }
        f32x4 v0, v1; unpack8(hc, v0, v1);
        const f32x4 g0 = *(const f32x4*)(g + c8), g1 = *(const f32x4*)(g + c8 + 4);
        *(f32x4*)(out + t * DM + c8) = v0 * rs * g0; *(f32x4*)(out + t * DM + c8 + 4) = v1 * rs * g1;
    }
}

#define XB_TMO      128
#define XB_XCNT(j)  (256  + 64 * (j))
#define XB_XSUB(j)  (1280 + 64 * (j))
#define XB_XGEN(j)  (2304 + 64 * (j))
#define XB_TOP      3328
#define XB_TOPGEN   3392
#define XCD_BAR_WORDS 3456
#define XB_SPIN_CAP (1u << 18)
__device__ __forceinline__ unsigned xb_ld(unsigned* p)              { return __hip_atomic_load(p, __ATOMIC_RELAXED, __HIP_MEMORY_SCOPE_AGENT); }
__device__ __forceinline__ unsigned xb_add(unsigned* p, unsigned v) { return __hip_atomic_fetch_add(p, v, __ATOMIC_RELAXED, __HIP_MEMORY_SCOPE_AGENT); }
__device__ __forceinline__ unsigned xb_xcc_id() { return (unsigned)__builtin_amdgcn_s_getreg((3 << 11) | 20) & 0xFu; }
#define XB_SPIN(cond, bar) do { unsigned _sp = 0; while (cond) { __builtin_amdgcn_s_sleep(1); \
    if ((++_sp & 255u) == 0u) { if (xb_ld(&(bar)[XB_TMO])) break; if (_sp > XB_SPIN_CAP) { atomicAdd(&(bar)[XB_TMO], 1u); break; } } } } while (0)
struct XcdBarrier { unsigned* bar; unsigned x; volatile LAS unsigned* st; };
__device__ __forceinline__ XcdBarrier xcd_barrier_post(unsigned* bar, volatile LAS unsigned* st) {
    XcdBarrier b; b.bar = bar; b.x = xb_xcc_id(); b.st = st;
    if (threadIdx.x == 0) (void)xb_add(&bar[XB_XCNT(b.x)], 1u);
    return b;
}
__device__ __forceinline__ void xcd_barrier_complete(unsigned* bar, unsigned x, unsigned& nloc, unsigned& nx) {
    const unsigned G = gridDim.x * gridDim.y * gridDim.z;
    unsigned sum, cnt, mine, sp = 0u;
    for (;;) {
        sum = 0u; cnt = 0u; mine = 0u;
#pragma unroll
        for (unsigned j = 0; j < 16; ++j) { const unsigned c = xb_ld(&bar[XB_XCNT(j)]); sum += c; cnt += (c > 0u) ? 1u : 0u; mine = (j == x) ? c : mine; }
        if (sum == G) break;
        __builtin_amdgcn_s_sleep(1);
        if ((++sp & 255u) == 0u) { if (xb_ld(&bar[XB_TMO])) break; if (sp > XB_SPIN_CAP) { atomicAdd(&bar[XB_TMO], 1u); break; } }
    }
    nloc = mine > 0u ? mine : 1u; nx = cnt > 0u ? cnt : 1u;
}
__device__ __forceinline__ void xcd_barrier(const XcdBarrier& b) {
    asm volatile("s_waitcnt vmcnt(0)" ::: "memory");
    __syncthreads();
    if (threadIdx.x == 0) {
        unsigned* bar = b.bar;
        __builtin_amdgcn_s_waitcnt(0);
        unsigned nloc = b.st[0], nx = b.st[1];
        if (nloc == 0u) { xcd_barrier_complete(bar, b.x, nloc, nx); b.st[0] = nloc; b.st[1] = nx; }
        const unsigned old = xb_add(&bar[XB_XSUB(b.x)], 1u);
        const unsigned gen = old / nloc;
        if (old + 1u == (gen + 1u) * nloc) {
            __builtin_amdgcn_fence(__ATOMIC_RELEASE, "agent");
            asm volatile("s_waitcnt vmcnt(0)" ::: "memory");
            const unsigned og = xb_add(&bar[XB_TOP], 1u);
            const unsigned tg = og / nx;
            if (og + 1u == (tg + 1u) * nx) xb_add(&bar[XB_TOPGEN], 1u);
            else XB_SPIN(xb_ld(&bar[XB_TOPGEN]) == tg, bar);
            __builtin_amdgcn_fence(__ATOMIC_ACQUIRE, "agent");
            xb_add(&bar[XB_XGEN(b.x)], 1u);
            asm volatile("s_waitcnt vmcnt(0)" ::: "memory");
        } else {
            XB_SPIN(xb_ld(&bar[XB_XGEN(b.x)]) == gen, bar);
            __builtin_amdgcn_fence(__ATOMIC_ACQUIRE, "agent");
            asm volatile("s_waitcnt vmcnt(0)" ::: "memory");
        }
    }
    __syncthreads();
}
constexpr size_t WS_BAR = 62 * MiB;

constexpr int NPHASE = 13;
__global__ void __launch_bounds__(512, 2) fwd_megakernel(Params p) {
    extern __shared__ __attribute__((aligned(16))) unsigned char lds_raw[];
    LAS unsigned char* lds = (LAS unsigned char*)lds_raw;
    unsigned char* ws = p.ws;
    const int G = gridDim.x, c = blockIdx.x;
    bf16_t* S0 = (bf16_t*)(ws + WS_S0); bf16_t* S1 = (bf16_t*)(ws + WS_S1); bf16_t* BIG = (bf16_t*)(ws + WS_BIG);
    bf16_t* B0 = BIG; bf16_t* B1 = BIG + SLOT / 2; bf16_t* B2 = BIG + SLOT; bf16_t* B3 = BIG + 3 * (SLOT / 2);
    float* ss1 = (float*)(ws + WS_SS1); float* ss2 = (float*)(ws + WS_SS2); float* ss3 = (float*)(ws + WS_SS3); float* ss4 = (float*)(ws + WS_SS4); float* ssr = (float*)(ws + WS_SSR);
    const int lo = p.ph_lo, hi = p.ph_hi;
    volatile LAS unsigned* xst = (volatile LAS unsigned*)(lds + pg8::STAGE_BYTES);
    if (threadIdx.x < 4) xst[threadIdx.x] = 0u;
    __syncthreads();
    XcdBarrier xbar = xcd_barrier_post((unsigned*)(ws + WS_BAR), xst);
    bf16_t* OLO = (bf16_t*)p.out; bf16_t* OHI = (bf16_t*)p.out + SLOT / 2;
#ifndef ENMASK
#define ENMASK 0x1fff
#endif
#define IN(k) (((ENMASK >> (k)) & 1) && lo <= (k) && (k) < hi)
#define SEAM(k) do { if (IN(k) && IN((k) + 1)) { if ((k) == 0) cg::this_grid().sync(); else xcd_barrier(xbar); } } while (0)
#ifndef REPMASK
#define REPMASK 0
#endif
#define NREP(k) (((REPMASK >> (k)) & 1) ? 2 : 1)
    float* dss = (float*)(ws + 60 * MiB); bf16_t* DUMB = (bf16_t*)(ws + 448 * MiB);
    if (IN(0)) for (int rep = NREP(0); rep > 0; --rep) p0_prologue(p, lds);
    SEAM(0);
    if (IN(1)) {
        pg8::Gemm g{S0, (const bf16_t*)(ws + WS_W1A), DM, DM, DM, 0}; pg8::StaticOrder S; S.init(MTOK, 2 * DFF, G, c, NREP(1));
        EpiSwiglu E{BIG, ss1}; pg8::gemm_phase(lds, g, S, E);
    }
    SEAM(1);
    if (IN(2)) {
        pg8::Gemm g{BIG, (const bf16_t*)(ws + WS_W1B), DFF, DFF, DFF, 0}; pg8::StaticOrder S; S.init(MTOK, DM, G, c, NREP(2));
        EpiResid<true> E{p.in[0], OLO, ss2, 0.5f, DUMB, dss}; pg8::gemm_phase(lds, g, S, E);
    }
    SEAM(2);
    bf16_t* S7 = (bf16_t*)(ws + 448 * MiB);
    if (IN(3)) {
#define RUN_QKV() do { pg8::Gemm g{OLO, (const bf16_t*)(ws + WS_WIN), DM, DM, DM, 0}; pg8::StaticOrder S; S.init(MTOK, 3072, G, c, NREP(3)); \
            EpiQKV E{BIG, ss2, (const float*)(ws + WS_COS), (const float*)(ws + WS_SIN)}; pg8::gemm_phase(lds, g, S, E); } while (0)
#define RUN_GATES() do { pg8::Gemm g{OLO, (const bf16_t*)(ws + WS_WIN) + (size_t)3072 * DM, DM, DM, DM, 0}; pg8::StaticOrder S; S.init(MTOK, 4096, G, c, NREP(5)); \
            EpiGates E{ws, OHI, ss2, p.in[6]}; pg8::gemm_phase(lds, g, S, E); } while (0)
        if ((c >> 3) & 1) { RUN_GATES(); RUN_QKV(); } else { RUN_QKV(); RUN_GATES(); }
#undef RUN_QKV
#undef RUN_GATES
    }
    SEAM(3);
    if (IN(4)) for (int rep = NREP(4); rep > 0; --rep) retention_phase(lds, B0, B1, B2, S0, rep > 1 ? dss : ssr);
    SEAM(4);
    if (IN(6)) for (int rep = NREP(6); rep > 0; --rep) mix_elementwise(S0, B0, B3, ssr, S1, B1);
    if (IN(5) && IN(6) && IN(7)) xcd_barrier(xbar);
    if (IN(7)) {
#define RUN_POOL() do {   \
            pg8::Gemm g{B1, (const bf16_t*)(ws + WS_WPL), DM, 256, 256, 256}; pg8::StaticOrder S; S.init(MTOK, DM, G, c, NREP(7)); \
            EpiScaleCol E{B2, p.in[8]}; pg8::gemm_phase(lds, g, S, E); } while (0)
#define RUN_RETUP() do {   \
            pg8::Gemm g{B0, (const bf16_t*)(ws + WS_WRU), DM, DM, DM, 0}; pg8::StaticOrder S; S.init(MTOK, DM, G, c, NREP(7)); \
            EpiGateMul<false> E{S0, S7, nullptr}; pg8::gemm_phase(lds, g, S, E); } while (0)
        if ((c >> 3) & 1) { RUN_RETUP(); RUN_POOL(); } else { RUN_POOL(); RUN_RETUP(); }
#undef RUN_POOL
#undef RUN_RETUP
    }
    SEAM(7);
    if (IN(8)) {
        pg8::Gemm g{B2, (const bf16_t*)(ws + WS_WPU), DM, DM, DM, 0}; pg8::StaticOrder S; S.init(MTOK, DM, G, c, NREP(8));
        EpiGateMul<true> E{S1, OHI, S0}; pg8::gemm_phase(lds, g, S, E);
    }
    SEAM(8);
    if (IN(9)) {
        pg8::Gemm g{S1, (const bf16_t*)(ws + WS_WO), DM, DM, DM, 0}; pg8::StaticOrder S; S.init(MTOK, DM, G, c, NREP(9));
        EpiResid<false> E{OLO, OHI, ss3, 1.0f, DUMB, dss}; pg8::gemm_phase(lds, g, S, E);
    }
    SEAM(9);
    if (IN(10)) {
        pg8::Gemm g{OHI, (const bf16_t*)(ws + WS_W2A), DM, DM, DM, 0}; pg8::StaticOrder S; S.init(MTOK, 2 * DFF, G, c, NREP(10));
        EpiSwiglu E{BIG, ss3}; pg8::gemm_phase(lds, g, S, E);
    }
    SEAM(10);
    if (IN(11)) {
        pg8::Gemm g{BIG, (const bf16_t*)(ws + WS_W2B), DFF, DFF, DFF, 0}; pg8::StaticOrder S; S.init(MTOK, DM, G, c, NREP(11));
        EpiResid<false> E{OHI, S1, ss4, 0.5f, DUMB, dss}; pg8::gemm_phase(lds, g, S, E);
    }
    SEAM(11);
    if (IN(12)) for (int rep = NREP(12); rep > 0; --rep) final_norm(S1, rep > 1 ? (float*)BIG : p.out, ss4, p.in[15]);
#undef IN
#undef SEAM
}

extern "C" void kernel_launch(void* const* d_in, const int* in_sizes, int n_in, void* d_out, int out_size, void* d_ws, size_t ws_size, hipStream_t stream) {
    constexpr int LDS_BYTES = pg8::STAGE_BYTES + 16;
    static int grid = 0;
    if (grid == 0) {
        if (n_in != 16 || out_size != MTOK * DM || ws_size < WS_END) { fprintf(stderr, "kernel_launch: unexpected shapes (n_in %d out %d ws %zu)\n", n_in, out_size, ws_size); grid = -1; return; }
        int dev = 0, cus = 0, per_cu = 0;
        (void)hipGetDevice(&dev); (void)hipDeviceGetAttribute(&cus, hipDeviceAttributeMultiprocessorCount, dev);
        if (hipFuncSetAttribute((const void*)fwd_megakernel, hipFuncAttributeMaxDynamicSharedMemorySize, LDS_BYTES) != hipSuccess) { fprintf(stderr, "kernel_launch: hipFuncSetAttribute failed\n"); grid = -1; return; }
        if (hipOccupancyMaxActiveBlocksPerMultiprocessor(&per_cu, (const void*)fwd_megakernel, 512, LDS_BYTES) != hipSuccess || per_cu < 1) { fprintf(stderr, "kernel_launch: occupancy query gave %d\n", per_cu); per_cu = 1; }
        (void)hipGetLastError();
        grid = cus;
    }
    if (grid < 0) return;
    if (hipMemsetAsync((char*)d_ws + WS_BAR, 0, XCD_BAR_WORDS * 4, stream) != hipSuccess) { fprintf(stderr, "kernel_launch: memset failed\n"); return; }
    Params p{};
    for (int i = 0; i < 16; ++i) p.in[i] = (const float*)d_in[i];
    p.out = (float*)d_out; p.ws = (unsigned char*)d_ws;
#if N_LAUNCH_MODE == 1
    p.ph_lo = 0; p.ph_hi = NPHASE;
    void* args[] = {&p};
    hipError_t e = hipLaunchCooperativeKernel((const void*)fwd_megakernel, dim3(grid), dim3(512), args, LDS_BYTES, stream);
    if (e != hipSuccess) fprintf(stderr, "cooperative launch failed: %s (grid %d)\n", hipGetErrorString(e), grid);
#else
    for (int ph = 0; ph < NPHASE; ++ph) { p.ph_lo = ph; p.ph_hi = ph + 1; hipLaunchKernelGGL(fwd_megakernel, dim3(grid), dim3(512), LDS_BYTES, stream, p); }
#endif
}
```

```cpp
#include <hip/hip_runtime.h>
#include <hip/hip_cooperative_groups.h>
#include <cstdio>
namespace cg = cooperative_groups;

#ifndef N_LAUNCH_MODE
#define N_LAUNCH_MODE 1
#endif

#define LAS __attribute__((address_space(3)))
typedef unsigned short bf16_t;
typedef short bf16x8 __attribute__((ext_vector_type(8)));
typedef short s16x4 __attribute__((ext_vector_type(4)));
typedef float f32x4 __attribute__((ext_vector_type(4)));
typedef unsigned u32x4 __attribute__((ext_vector_type(4)));
typedef unsigned u32x2 __attribute__((ext_vector_type(2)));

constexpr int MTOK = 32768, DM = 1024, DFF = 2816, SEQ = 4096, NIN = 7168;
constexpr float EPS = 1e-6f;

constexpr size_t MiB = 1024ull * 1024ull;
constexpr size_t WS_W1A = 0;
constexpr size_t WS_W1B = WS_W1A + 5632ull * 1024 * 2;
constexpr size_t WS_WIN = WS_W1B + 1024ull * 2816 * 2;
constexpr size_t WS_WPL = WS_WIN + 7168ull * 1024 * 2;
constexpr size_t WS_WRU = WS_WPL + 1024ull * 256 * 2;
constexpr size_t WS_WPU = WS_WRU + 1024ull * 1024 * 2;
constexpr size_t WS_WO  = WS_WPU + 1024ull * 1024 * 2;
constexpr size_t WS_W2A = WS_WO + 1024ull * 1024 * 2;
constexpr size_t WS_W2B = WS_W2A + 5632ull * 1024 * 2;
constexpr size_t WS_COS = WS_W2B + 1024ull * 2816 * 2;
constexpr size_t WS_SIN = WS_COS + 4096ull * 128 * 4;
constexpr size_t WS_SS1 = WS_SIN + 4096ull * 128 * 4;
constexpr size_t WS_SS2 = WS_SS1 + MTOK * 4ull;
constexpr size_t WS_SS3 = WS_SS2 + MTOK * 4ull;
constexpr size_t WS_SS4 = WS_SS3 + MTOK * 4ull;
constexpr size_t WS_SSR = WS_SS4 + MTOK * 4ull;
constexpr size_t WS_SMALL_END = WS_SSR + MTOK * 16ull;
static_assert(WS_SMALL_END <= 64 * MiB, "weights region");
constexpr size_t WS_S0 = 64 * MiB;
constexpr size_t WS_S1 = 128 * MiB;
constexpr size_t WS_BIG = 192 * MiB;
constexpr size_t WS_END = 512 * MiB;
constexpr size_t SLOT = 64 * MiB;

namespace pg8 {
constexpr int BM = 256, BK = 64, HALF = 128, HTB = HALF * BK * 2, STAGE_BYTES = 8 * HTB, NXCD = 8, WGM = 8;
__host__ __device__ __forceinline__ int lds_byte(int r, int c) { const int st = (r >> 4) * 2 + (c >> 5), rr = r & 15, cc = c & 31, ob = rr * 64 + cc * 2; return st * 1024 + (ob ^ (((ob >> 9) & 1) << 5)); }
__host__ __device__ __forceinline__ void stage_rc(int b, int& R, int& C) { const int st = b / 1024, sb = b % 1024, swz = sb ^ (((sb >> 9) & 1) << 5); R = (st >> 1) * 16 + swz / 64; C = (st & 1) * 32 + (swz % 64) / 2; }
__host__ __device__ __forceinline__ int perm32(int rho) { const int n = rho >> 4, i = rho & 15; return 8 * (i >> 2) + 4 * n + (i & 3); }

struct Unit { int pm, pn, pass; };
struct Gemm { const bf16_t* A; const bf16_t* Bt; int lda, ldb, K; int a_pn_off; };

struct StaticOrder {
    int nM, nN, nwg, G, c, rept;
    __host__ __device__ void init(int M, int N, int G_, int c_, int rept_ = 1) { nM = M / BM; nN = N / BM; nwg = nM * nN; G = G_; c = c_; rept = rept_; }
    __host__ __device__ bool next(int i, Unit& u) const {
        u.pass = 0;
        if (rept > 1) { const int ni = (nwg - c + G - 1) / G; if (ni <= 0 || i >= ni * rept) return false; u.pass = rept - 1 - i / ni; i = i % ni; }
        const long L = (long)i * G + c; if (L >= nwg) return false;
        int wgid = (int)L; { const int q = nwg / NXCD, r = nwg % NXCD, xcd = wgid % NXCD, off = wgid / NXCD; wgid = (xcd < r ? xcd * (q + 1) : r * (q + 1) + (xcd - r) * q) + off; }
        const int nig = WGM * nN, gid = wgid / nig, fm = gid * WGM, gsz = (nM - fm) < WGM ? (nM - fm) : WGM;
        u.pm = fm + ((wgid % nig) % gsz); u.pn = (wgid % nig) / gsz; return true;
    }
};
typedef float f32x2_t __attribute__((ext_vector_type(2)));
typedef __bf16 bf16x2_t __attribute__((ext_vector_type(2)));
__device__ __forceinline__ unsigned cvt_pk_bf16(float lo, float hi) { f32x2_t v = {lo, hi}; bf16x2_t b = __builtin_convertvector(v, bf16x2_t); return __builtin_bit_cast(unsigned, b); }

template <class Epi>
__device__ __forceinline__ void gemm_phase(LAS unsigned char* lds, const Gemm g, const StaticOrder& S, const Epi& E) {
    const int tid = threadIdx.x, wid = __builtin_amdgcn_readfirstlane(tid >> 6), lane = tid & 63, wr = wid >> 2, wc = wid & 3, fr = lane & 15, fq = lane >> 4;
    const int K = g.K, nt = K / BK;
    unsigned voffA[2], voffB[2];
#pragma unroll
    for (int i = 0; i < 2; ++i) { int R, C; stage_rc(tid * 16 + i * 8192, R, C); const int Rb = Epi::PERM ? ((R & ~31) + perm32(R & 31)) : R;
        voffA[i] = (unsigned)(R * g.lda + C) * 2u; voffB[i] = (unsigned)(Rb * g.ldb + C) * 2u; }
    const size_t kstep = (size_t)(BK * 2);
    const size_t hstepA = (size_t)HALF * g.lda * 2, hstepB = (size_t)HALF * g.ldb * 2;
    const size_t tstepA = 2 * hstepA, tstepB = 2 * hstepB;
    const unsigned ldsw = (unsigned)wid * 1024u;
    const int aoff = lds_byte(wr * 64 + fr, fq * 8), boff = lds_byte(wc * 32 + fr, fq * 8);
#define PG8_SA(b, h) (((b) * 2 + (h)) * HTB)
#define PG8_SB(b, h) ((4 + (b) * 2 + (h)) * HTB)
#define PG8_STAGE(bufoff, gbase, voff) do { _Pragma("unroll") for (int _i = 0; _i < 2; ++_i) \
        __builtin_amdgcn_global_load_lds((const unsigned*)((const char*)(gbase) + (voff)[_i]), (LAS unsigned*)(lds + (bufoff) + ldsw + _i * 8192), 16, 0, 0); } while (0)
#define PG8_LDA(dst, b, h) do { _Pragma("unroll") for (int m = 0; m < 4; ++m) _Pragma("unroll") for (int k = 0; k < 2; ++k) dst[m][k] = *(const LAS bf16x8*)(lds + PG8_SA(b, h) + aoff + m * 2048 + k * 1024); } while (0)
#define PG8_LDB(dst, b, h) do { _Pragma("unroll") for (int n = 0; n < 2; ++n) _Pragma("unroll") for (int k = 0; k < 2; ++k) dst[n][k] = *(const LAS bf16x8*)(lds + PG8_SB(b, h) + boff + n * 2048 + k * 1024); } while (0)
#define PG8_MMA(ai, bj, At, Bt) do { __builtin_amdgcn_s_setprio(1); _Pragma("unroll") for (int m = 0; m < 4; ++m) _Pragma("unroll") for (int n = 0; n < 2; ++n) _Pragma("unroll") for (int k = 0; k < 2; ++k) \
        acc[ai][bj][m][n] = __builtin_amdgcn_mfma_f32_16x16x32_bf16(Bt[n][k], At[m][k], acc[ai][bj][m][n], 0, 0, 0); __builtin_amdgcn_s_setprio(0); } while (0)
#define PG8_WAIT_V(n) asm volatile("s_waitcnt vmcnt(" #n ")" ::: "memory")
#define PG8_WAIT_L(n) asm volatile("s_waitcnt lgkmcnt(" #n ")" ::: "memory")
#define PG8_BAR __builtin_amdgcn_s_barrier()
#define PG8_SCHED __builtin_amdgcn_sched_barrier(0)
    Unit cur, nxt; int ui = 0;
    if (!S.next(0, cur)) return;
    typename Epi::Pre pre;
    f32x4 acc[2][2][4][2];
#pragma unroll
    for (int a = 0; a < 2; ++a)
#pragma unroll
        for (int b = 0; b < 2; ++b)
#pragma unroll
            for (int m = 0; m < 4; ++m)
#pragma unroll
                for (int n = 0; n < 2; ++n) acc[a][b][m][n] = (f32x4){0.f, 0.f, 0.f, 0.f};
    bf16x8 At[4][2], B0[2][2], B1[2][2];
    const char* cA = (const char*)g.A + (size_t)cur.pm * tstepA + (size_t)cur.pn * g.a_pn_off * 2; const char* cB = (const char*)g.Bt + (size_t)cur.pn * tstepB;
    PG8_STAGE(PG8_SB(0, 0), cB, voffB); PG8_STAGE(PG8_SB(0, 1), cB + hstepB, voffB); PG8_STAGE(PG8_SA(0, 0), cA, voffA); PG8_STAGE(PG8_SA(0, 1), cA + hstepA, voffA);
    if (wr == 1) PG8_BAR;
    PG8_WAIT_V(2); PG8_BAR;
    PG8_STAGE(PG8_SB(1, 0), cB + kstep, voffB); PG8_STAGE(PG8_SA(1, 0), cA + kstep, voffA); PG8_STAGE(PG8_SB(1, 1), cB + hstepB + kstep, voffB);
    PG8_WAIT_V(6); PG8_BAR;
    for (;;) {
        const bool has_next = S.next(ui + 1, nxt);
        const char* nA = has_next ? (const char*)g.A + (size_t)nxt.pm * tstepA + (size_t)nxt.pn * g.a_pn_off * 2 : cA; const char* nB = has_next ? (const char*)g.Bt + (size_t)nxt.pn * tstepB : cB;
#pragma unroll 1
        for (int t = 0; t < nt; t += 2) {
            const bool last = (t == nt - 2);
            const char* a1 = cA + (size_t)(t + 1) * kstep;
            const char* a2 = last ? nA : cA + (size_t)(t + 2) * kstep; const char* b2 = last ? nB : cB + (size_t)(t + 2) * kstep;
            const char* a3 = a2 + kstep; const char* b3 = b2 + kstep;
            if (last) E.prefetch(pre, cur, wr, wc, fr, fq);
            PG8_LDB(B0, 0, 0); PG8_LDB(B1, 0, 1); PG8_SCHED; PG8_LDA(At, 0, 0); PG8_STAGE(PG8_SA(1, 1), a1 + hstepA, voffA);
            PG8_WAIT_V(8); PG8_WAIT_L(0); PG8_BAR; PG8_MMA(0, 0, At, B0); PG8_MMA(0, 1, At, B1); PG8_BAR; PG8_SCHED;
            PG8_LDA(At, 0, 1); PG8_STAGE(PG8_SB(0, 0), b2, voffB); PG8_STAGE(PG8_SB(0, 1), b2 + hstepB, voffB); PG8_STAGE(PG8_SA(0, 0), a2, voffA);
            PG8_WAIT_V(8); PG8_WAIT_L(0); PG8_BAR; PG8_MMA(1, 0, At, B0); PG8_MMA(1, 1, At, B1); PG8_BAR; PG8_SCHED;
            PG8_LDB(B0, 1, 0); PG8_LDB(B1, 1, 1); PG8_SCHED; PG8_LDA(At, 1, 0); PG8_STAGE(PG8_SA(0, 1), a2 + hstepA, voffA);
            PG8_WAIT_V(8); PG8_WAIT_L(0); PG8_BAR; PG8_MMA(0, 0, At, B0); PG8_MMA(0, 1, At, B1); PG8_BAR; PG8_SCHED;
            PG8_LDA(At, 1, 1); PG8_STAGE(PG8_SB(1, 0), b3, voffB); PG8_STAGE(PG8_SB(1, 1), b3 + hstepB, voffB); PG8_STAGE(PG8_SA(1, 0), a3, voffA);
            PG8_WAIT_V(8); PG8_WAIT_L(0); PG8_BAR; PG8_MMA(1, 0, At, B0); PG8_MMA(1, 1, At, B1); PG8_BAR; PG8_SCHED;
        }
        if (wr == 0) PG8_BAR;
        E(acc, pre, cur, wr, wc, fr, fq);
        if (wr == 1) PG8_BAR;
        if (!has_next) break;
#pragma unroll
        for (int a = 0; a < 2; ++a)
#pragma unroll
            for (int b = 0; b < 2; ++b)
#pragma unroll
                for (int m = 0; m < 4; ++m)
#pragma unroll
                    for (int n = 0; n < 2; ++n) acc[a][b][m][n] = (f32x4){0.f, 0.f, 0.f, 0.f};
        cur = nxt; cA = nA; cB = nB; ++ui;
    }
    PG8_WAIT_V(0);
    if (wr == 0) PG8_BAR;
    PG8_BAR;
#undef PG8_SA
#undef PG8_SB
#undef PG8_STAGE
#undef PG8_LDA
#undef PG8_LDB
#undef PG8_MMA
#undef PG8_WAIT_V
#undef PG8_WAIT_L
#undef PG8_BAR
#undef PG8_SCHED
}
}
using pg8::cvt_pk_bf16;
using pg8::Unit;

__device__ __forceinline__ float sigm_f(float g) { return __builtin_amdgcn_rcpf(1.0f + __builtin_amdgcn_exp2f(g * -1.4426950408889634f)); }
__device__ __forceinline__ float silu_f(float g) { return g * sigm_f(g); }
__device__ __forceinline__ f32x4 sigm4(const f32x4 g) { const f32x4 a = g * -1.4426950408889634f; f32x4 e; e[0] = __builtin_amdgcn_exp2f(a[0]); e[1] = __builtin_amdgcn_exp2f(a[1]); e[2] = __builtin_amdgcn_exp2f(a[2]); e[3] = __builtin_amdgcn_exp2f(a[3]);
    const f32x4 d = e + 1.0f; f32x4 r; r[0] = __builtin_amdgcn_rcpf(d[0]); r[1] = __builtin_amdgcn_rcpf(d[1]); r[2] = __builtin_amdgcn_rcpf(d[2]); r[3] = __builtin_amdgcn_rcpf(d[3]); return r; }
__device__ __forceinline__ float rs_of(float ss) { return __builtin_amdgcn_rsqf(ss * (1.0f / 1024.0f) + EPS); }
__device__ __forceinline__ float bf2f(unsigned short b) { return __uint_as_float(((unsigned)b) << 16); }
__device__ __forceinline__ u32x4 pack8(const f32x4 a, const f32x4 b) { u32x4 w; w.x = cvt_pk_bf16(a[0], a[1]); w.y = cvt_pk_bf16(a[2], a[3]); w.z = cvt_pk_bf16(b[0], b[1]); w.w = cvt_pk_bf16(b[2], b[3]); return w; }
__device__ __forceinline__ void unpack8(const u32x4 w, f32x4& a, f32x4& b) {
    a[0] = __uint_as_float(w.x << 16); a[1] = __uint_as_float(w.x & 0xffff0000u); a[2] = __uint_as_float(w.y << 16); a[3] = __uint_as_float(w.y & 0xffff0000u);
    b[0] = __uint_as_float(w.z << 16); b[1] = __uint_as_float(w.z & 0xffff0000u); b[2] = __uint_as_float(w.w << 16); b[3] = __uint_as_float(w.w & 0xffff0000u); }

#define ROWOF(ri) (row0 + ((ri) >> 2) * 128 + ((ri) & 3) * 16)
#define ACC(ri, bj, n) acc[(ri) >> 2][bj][(ri) & 3][n]
struct EpiSwiglu {
    static constexpr bool PERM = true;
    struct Pre {};
    __device__ __forceinline__ void prefetch(Pre&, const Unit&, int, int, int, int) const {}
    bf16_t* O; const float* ss;
    __device__ __forceinline__ void operator()(const f32x4 (&acc)[2][2][4][2], Pre& pre, const Unit& u, int wr, int wc, int fr, int fq) const {
        const int row0 = u.pm * 256 + wr * 64 + fr, col0 = u.pn * 128 + wc * 32 + 8 * fq;
        float ssv[8];
#pragma unroll
        for (int ri = 0; ri < 8; ++ri) ssv[ri] = ss[ROWOF(ri)];
#pragma unroll
        for (int ri = 0; ri < 8; ++ri) { const int r = ROWOF(ri); const float rs = rs_of(ssv[ri]);
            f32x4 o[2];
#pragma unroll
            for (int n = 0; n < 2; ++n) { const f32x4 gt = ACC(ri, 0, n) * rs, up = ACC(ri, 1, n) * rs; o[n] = (gt * up) * sigm4(gt); }
            *(u32x4*)(O + (size_t)r * DFF + col0) = pack8(o[0], o[1]); }
    }
};
template <bool IN_F32> struct EpiResid {
    static constexpr bool PERM = true;
    struct Pre {};
    __device__ __forceinline__ void prefetch(Pre&, const Unit&, int, int, int, int) const {}
    const void* hin; bf16_t* hb_; float* ss_; float scale; bf16_t* hb_d; float* ss_d;
    __device__ __forceinline__ void ldrow(size_t off, f32x4 (&b)[2][2]) const {
#pragma unroll
        for (int bj = 0; bj < 2; ++bj) {
            if (IN_F32) { b[bj][0] = *(const f32x4*)((const float*)hin + off + bj * 128); b[bj][1] = *(const f32x4*)((const float*)hin + off + bj * 128 + 4); }
            else unpack8(*(const u32x4*)((const bf16_t*)hin + off + bj * 128), b[bj][0], b[bj][1]); }
    }
    __device__ __forceinline__ void operator()(const f32x4 (&acc)[2][2][4][2], Pre& pre, const Unit& u, int wr, int wc, int fr, int fq) const {
        bf16_t* hb = hb_; float* ss = ss_;
        if (u.pass > 0) { hb = hb_d; ss = ss_d; }
        const int row0 = u.pm * 256 + wr * 64 + fr, col0 = u.pn * 256 + wc * 32 + 8 * fq;
        f32x4 bb[2][2][2];
        ldrow((size_t)ROWOF(0) * DM + col0, bb[0]);
#pragma unroll
        for (int ri = 0; ri < 8; ++ri) { const int r = ROWOF(ri); const size_t off = (size_t)r * DM + col0; float q = 0.f;
            if (ri < 7) ldrow((size_t)ROWOF(ri + 1) * DM + col0, bb[(ri + 1) & 1]);
#pragma unroll
            for (int bj = 0; bj < 2; ++bj) {
                const f32x4 o0 = bb[ri & 1][bj][0] + ACC(ri, bj, 0) * scale, o1 = bb[ri & 1][bj][1] + ACC(ri, bj, 1) * scale;
                *(u32x4*)(hb + off + bj * 128) = pack8(o0, o1);
                q += ((o0[0] * o0[0] + o0[1] * o0[1]) + (o0[2] * o0[2] + o0[3] * o0[3])) + ((o1[0] * o1[0] + o1[1] * o1[1]) + (o1[2] * o1[2] + o1[3] * o1[3])); }
            q += __shfl_xor(q, 16); q += __shfl_xor(q, 32);
            if (fq == 0) atomicAdd(ss + r, q); }
    }
};
struct EpiQKV {
    static constexpr bool PERM = true;
    struct Pre {};
    __device__ __forceinline__ void prefetch(Pre&, const Unit&, int, int, int, int) const {}
    bf16_t* QKV; const float* ss; const float* cosT; const float* sinT;
    __device__ __forceinline__ void operator()(const f32x4 (&acc)[2][2][4][2], Pre& pre, const Unit& u, int wr, int wc, int fr, int fq) const {
        const int sect = u.pn >> 2, hd = u.pn & 3; bf16_t* base = QKV + (size_t)sect * (SLOT / 2);
        const int row0 = u.pm * 256 + wr * 64 + fr, j0 = wc * 32 + 8 * fq; const float ksc = sect == 1 ? 0.0625f : 1.0f;
        float ssv[8];
#pragma unroll
        for (int ri = 0; ri < 8; ++ri) ssv[ri] = ss[ROWOF(ri)];
        f32x4 cs[2][2][2];
#pragma unroll
        for (int n = 0; n < 2; ++n) { cs[0][0][n] = (f32x4){1.f, 1.f, 1.f, 1.f}; cs[0][1][n] = (f32x4){0.f, 0.f, 0.f, 0.f}; cs[1][0][n] = cs[0][0][n]; cs[1][1][n] = cs[0][1][n]; }
        if (sect < 2) { const int pos = ROWOF(0) & (SEQ - 1);
#pragma unroll
            for (int n = 0; n < 2; ++n) { cs[0][0][n] = *(const f32x4*)(cosT + pos * 128 + j0 + 4 * n); cs[0][1][n] = *(const f32x4*)(sinT + pos * 128 + j0 + 4 * n); } }
#pragma unroll
        for (int ri = 0; ri < 8; ++ri) { const int r = ROWOF(ri); const float rs = rs_of(ssv[ri]);
            if (ri < 7 && sect < 2) { const int pos = ROWOF(ri + 1) & (SEQ - 1);
#pragma unroll
                for (int n = 0; n < 2; ++n) { cs[(ri + 1) & 1][0][n] = *(const f32x4*)(cosT + pos * 128 + j0 + 4 * n); cs[(ri + 1) & 1][1][n] = *(const f32x4*)(sinT + pos * 128 + j0 + 4 * n); } }
            f32x4 o1[2], o2[2];
#pragma unroll
            for (int n = 0; n < 2; ++n) { const f32x4 c = cs[ri & 1][0][n], sn = cs[ri & 1][1][n];
                const f32x4 x1 = ACC(ri, 0, n) * rs, x2 = ACC(ri, 1, n) * rs; o1[n] = (x1 * c - x2 * sn) * ksc; o2[n] = (x1 * sn + x2 * c) * ksc; }
            bf16_t* rp = base + (size_t)r * DM + hd * 256 + j0;
            *(u32x4*)(rp) = pack8(o1[0], o1[1]); *(u32x4*)(rp + 128) = pack8(o2[0], o2[1]); }
    }
};
struct EpiGates {
    static constexpr bool PERM = true;
    struct Pre {};
    __device__ __forceinline__ void prefetch(Pre&, const Unit&, int, int, int, int) const {}
    unsigned char* wsb; bf16_t* ohi; const float* ss; const float* gbias;
    __device__ __forceinline__ void operator()(const f32x4 (&acc)[2][2][4][2], Pre& pre, const Unit& u, int wr, int wc, int fr, int fq) const {
        const int sect = u.pn >> 2, ct = (u.pn & 3) * 256; bf16_t* O = sect == 3 ? ohi : (bf16_t*)(wsb + (size_t)((0x726u >> (4 * sect)) & 0xFu) * SLOT);
        const int row0 = u.pm * 256 + wr * 64 + fr, c0 = ct + wc * 32 + 8 * fq;
        float ssv[8];
#pragma unroll
        for (int ri = 0; ri < 8; ++ri) ssv[ri] = ss[ROWOF(ri)];
        f32x4 bv[2][2];
#pragma unroll
        for (int bj = 0; bj < 2; ++bj)
#pragma unroll
            for (int n = 0; n < 2; ++n) bv[bj][n] = sect >= 2 ? *(const f32x4*)(gbias + (sect - 2) * DM + c0 + bj * 128 + 4 * n) : (f32x4){0.f, 0.f, 0.f, 0.f};
#pragma unroll
        for (int ri = 0; ri < 8; ++ri) { const int r = ROWOF(ri); const float rs = rs_of(ssv[ri]);
#pragma unroll
            for (int bj = 0; bj < 2; ++bj) { f32x4 o[2];
#pragma unroll
                for (int n = 0; n < 2; ++n) { const f32x4 v = ACC(ri, bj, n) * rs + bv[bj][n]; o[n] = v; if (sect != 1) { const f32x4 sg = sigm4(v); o[n] = sect == 0 ? v * sg : sg; } }
                *(u32x4*)(O + (size_t)r * DM + c0 + bj * 128) = pack8(o[0], o[1]); } }
    }
};
struct EpiScaleCol {
    static constexpr bool PERM = true;
    struct Pre {};
    __device__ __forceinline__ void prefetch(Pre&, const Unit&, int, int, int, int) const {}
    bf16_t* O; const float* scale;
    __device__ __forceinline__ void operator()(const f32x4 (&acc)[2][2][4][2], Pre& pre, const Unit& u, int wr, int wc, int fr, int fq) const {
        const int row0 = u.pm * 256 + wr * 64 + fr, c0 = u.pn * 256 + wc * 32 + 8 * fq;
        f32x4 sv[2][2];
#pragma unroll
        for (int bj = 0; bj < 2; ++bj)
#pragma unroll
            for (int n = 0; n < 2; ++n) sv[bj][n] = *(const f32x4*)(scale + c0 + bj * 128 + 4 * n);
#pragma unroll
        for (int ri = 0; ri < 8; ++ri) { const int r = ROWOF(ri);
#pragma unroll
            for (int bj = 0; bj < 2; ++bj) *(u32x4*)(O + (size_t)r * DM + c0 + bj * 128) = pack8(ACC(ri, bj, 0) * sv[bj][0], ACC(ri, bj, 1) * sv[bj][1]); }
    }
};
template <bool ADD> struct EpiGateMul {
    static constexpr bool PERM = true;
    struct Pre {};
    __device__ __forceinline__ void prefetch(Pre&, const Unit&, int, int, int, int) const {}
    bf16_t* O; const bf16_t* G; const bf16_t* Min;
    __device__ __forceinline__ void ldrow(size_t off, u32x4 (&g)[2], u32x4 (&a)[2]) const {
#pragma unroll
        for (int bj = 0; bj < 2; ++bj) { g[bj] = *(const u32x4*)(G + off + bj * 128); if (ADD) a[bj] = *(const u32x4*)(Min + off + bj * 128); }
    }
    __device__ __forceinline__ void operator()(const f32x4 (&acc)[2][2][4][2], Pre& pre, const Unit& u, int wr, int wc, int fr, int fq) const {
        const int row0 = u.pm * 256 + wr * 64 + fr, c0 = u.pn * 256 + wc * 32 + 8 * fq;
        u32x4 gb[2][2], ab[2][2];
        ldrow((size_t)ROWOF(0) * DM + c0, gb[0], ab[0]);
#pragma unroll
        for (int ri = 0; ri < 8; ++ri) { const size_t off = (size_t)ROWOF(ri) * DM + c0;
            if (ri < 7) ldrow((size_t)ROWOF(ri + 1) * DM + c0, gb[(ri + 1) & 1], ab[(ri + 1) & 1]);
#pragma unroll
            for (int bj = 0; bj < 2; ++bj) {
                f32x4 g0, g1; unpack8(gb[ri & 1][bj], g0, g1);
                f32x4 o0 = g0 * ACC(ri, bj, 0), o1 = g1 * ACC(ri, bj, 1);
                if (ADD) { f32x4 a0, a1; unpack8(ab[ri & 1][bj], a0, a1); o0 += a0; o1 += a1; }
                *(u32x4*)(O + off + bj * 128) = pack8(o0, o1); } }
    }
};

__device__ __forceinline__ unsigned pk2(float lo, float hi) { return cvt_pk_bf16(lo, hi); }
template <int MODE>
__device__ __forceinline__ void p0_transpose_item(const float* W, int ldw, bf16_t* WT, int ldt, int nblk, const float* gain, LAS float* scr, int item, int lane) {
    const int kb = item / nblk, nb = item % nblk, k0 = 64 * kb, n0 = 32 * nb;
    int sc0 = n0;
    if (MODE == 1) { const int tile = n0 >> 8, r = n0 & 255; sc0 = (r >> 7) * DFF + 128 * tile + (r & 127); }
    f32x4 v[8]; float gv[8];
#pragma unroll
    for (int i = 0; i < 8; ++i) { const int kk = 8 * i + (lane >> 3); v[i] = *(const f32x4*)(W + (size_t)(k0 + kk) * ldw + sc0 + (lane & 7) * 4); gv[i] = gain ? gain[k0 + kk] : 1.0f; }
#pragma unroll
    for (int i = 0; i < 8; ++i) { const int kk = 8 * i + (lane >> 3); LAS float* d = scr + kk * 33 + (lane & 7) * 4;
        d[0] = v[i][0] * gv[i]; d[1] = v[i][1] * gv[i]; d[2] = v[i][2] * gv[i]; d[3] = v[i][3] * gv[i]; }
    asm volatile("s_waitcnt lgkmcnt(0)" ::: "memory");
    const int c = lane & 7;
#pragma unroll
    for (int j = 0; j < 4; ++j) { const int n = (lane >> 3) + 8 * j; const LAS float* s = scr + (8 * c) * 33 + n;
        u32x4 o; o.x = pk2(s[0 * 33], s[1 * 33]); o.y = pk2(s[2 * 33], s[3 * 33]); o.z = pk2(s[4 * 33], s[5 * 33]); o.w = pk2(s[6 * 33], s[7 * 33]);
        *(u32x4*)(WT + (size_t)(n0 + n) * ldt + k0 + 8 * c) = o; }
    asm volatile("s_waitcnt lgkmcnt(0)" ::: "memory");
}

struct Params {
    const float* in[16];
    float* out; unsigned char* ws;
    int ph_lo, ph_hi;
};

__device__ __forceinline__ void p0_prologue(const Params& p, LAS unsigned char* lds) {
    const int tid = threadIdx.x, lane = tid & 63, wave = tid >> 6;
    const int G = gridDim.x, gw = blockIdx.x * 8 + wave, NGW = G * 8;
    unsigned char* ws = p.ws;
    LAS float* scr = (LAS float*)(lds + wave * 16384);
    constexpr int I_1A = 16 * 176, I_1B = 44 * 32, I_IN = 16 * 224, I_PL = 4 * 32, I_SQ = 16 * 32;
    constexpr int NITEMS = 2 * I_1A + 2 * I_1B + I_IN + I_PL + 3 * I_SQ;
    for (int it = gw; it < NITEMS; it += NGW) {
        int r = it;
        if (r < I_1A) { p0_transpose_item<1>(p.in[2], 2 * DFF, (bf16_t*)(ws + WS_W1A), DM, 176, p.in[1], scr, r, lane); continue; } r -= I_1A;
        if (r < I_1A) { p0_transpose_item<1>(p.in[13], 2 * DFF, (bf16_t*)(ws + WS_W2A), DM, 176, p.in[12], scr, r, lane); continue; } r -= I_1A;
        if (r < I_1B) { p0_transpose_item<0>(p.in[3], DM, (bf16_t*)(ws + WS_W1B), DFF, 32, nullptr, scr, r, lane); continue; } r -= I_1B;
        if (r < I_1B) { p0_transpose_item<0>(p.in[14], DM, (bf16_t*)(ws + WS_W2B), DFF, 32, nullptr, scr, r, lane); continue; } r -= I_1B;
        if (r < I_IN) { p0_transpose_item<0>(p.in[5], NIN, (bf16_t*)(ws + WS_WIN), DM, 224, p.in[4], scr, r, lane); continue; } r -= I_IN;
        if (r < I_PL) { const int g = r >> 5; p0_transpose_item<0>(p.in[7] + (size_t)g * 65536, 256, (bf16_t*)(ws + WS_WPL) + (size_t)g * 65536, 256, 8, nullptr, scr, r & 31, lane); continue; } r -= I_PL;
        if (r < I_SQ) { p0_transpose_item<0>(p.in[9], DM, (bf16_t*)(ws + WS_WRU), DM, 32, nullptr, scr, r, lane); continue; } r -= I_SQ;
        if (r < I_SQ) { p0_transpose_item<0>(p.in[10], DM, (bf16_t*)(ws + WS_WPU), DM, 32, nullptr, scr, r, lane); continue; } r -= I_SQ;
        p0_transpose_item<0>(p.in[11], DM, (bf16_t*)(ws + WS_WO), DM, 32, nullptr, scr, r, lane);
    }
    const float* x = p.in[0]; bf16_t* XB = (bf16_t*)(ws + WS_S0); float* ss1 = (float*)(ws + WS_SS1);
    {
        f32x4 vn[4];
        if (gw < MTOK) { const f32x4* xr = (const f32x4*)(x + (size_t)gw * DM) + lane;
#pragma unroll
            for (int j = 0; j < 4; ++j) vn[j] = xr[64 * j]; }
        for (int m = gw; m < MTOK; m += NGW) {
            f32x4 v[4]; float s = 0.f;
#pragma unroll
            for (int j = 0; j < 4; ++j) v[j] = vn[j];
            if (m + NGW < MTOK) { const f32x4* xr = (const f32x4*)(x + (size_t)(m + NGW) * DM) + lane;
#pragma unroll
                for (int j = 0; j < 4; ++j) vn[j] = xr[64 * j]; }
#pragma unroll
            for (int j = 0; j < 4; ++j) s += (v[j][0] * v[j][0] + v[j][1] * v[j][1]) + (v[j][2] * v[j][2] + v[j][3] * v[j][3]);
#pragma unroll
            for (int o = 1; o < 64; o <<= 1) s += __shfl_xor(s, o);
            u32x2* o8 = (u32x2*)(XB + (size_t)m * DM) + lane;
#pragma unroll
            for (int j = 0; j < 4; ++j) { u32x2 w; w.x = pk2(v[j][0], v[j][1]); w.y = pk2(v[j][2], v[j][3]); o8[64 * j] = w; }
            if (lane == 0) ss1[m] = s;
        }
    }
    const int gt = blockIdx.x * 512 + tid, NGT = G * 512;
    float* cosT = (float*)(ws + WS_COS); float* sinT = (float*)(ws + WS_SIN);
    for (int i = gt; i < SEQ * 128; i += NGT) { const int pos = i >> 7, j = i & 127;
        const float inv = exp2f(-(float)j * (13.287712379549449f / 128.0f)); const float ang = (float)pos * inv;
        const double rev = (double)ang * 0.15915494309189533577; const float fr_ = (float)(rev - rint(rev));
        cosT[i] = __builtin_amdgcn_cosf(fr_); sinT[i] = __builtin_amdgcn_sinf(fr_); }
    float* z = (float*)(ws + WS_SS2);
    for (int i = gt; i < MTOK * 3 + MTOK * 4; i += NGT) z[i] = 0.f;
}

template <int O0, int O1, int O2, int O3>
__device__ __forceinline__ void tr4(unsigned addr, s16x4& a, s16x4& b, s16x4& c, s16x4& d) {
    asm volatile("ds_read_b64_tr_b16 %0, %4 offset:%5\n\tds_read_b64_tr_b16 %1, %4 offset:%6\n\tds_read_b64_tr_b16 %2, %4 offset:%7\n\tds_read_b64_tr_b16 %3, %4 offset:%8"
                 : "=&v"(a), "=&v"(b), "=&v"(c), "=&v"(d) : "v"(addr), "i"(O0), "i"(O1), "i"(O2), "i"(O3) : "memory");
}
__device__ __forceinline__ void tr_wait4(s16x4& a, s16x4& b, s16x4& c, s16x4& d) { asm volatile("s_waitcnt lgkmcnt(0)" : "+v"(a), "+v"(b), "+v"(c), "+v"(d) :: "memory"); }
__device__ __forceinline__ bf16x8 cat8(const s16x4 a, const s16x4 b) { bf16x8 r; r[0] = a[0]; r[1] = a[1]; r[2] = a[2]; r[3] = a[3]; r[4] = b[0]; r[5] = b[1]; r[6] = b[2]; r[7] = b[3]; return r; }
__device__ __forceinline__ unsigned short f2bf(float f) { unsigned u = __float_as_uint(f); u += 0x7fffu + ((u >> 16) & 1u); return (unsigned short)(u >> 16); }
__device__ __forceinline__ unsigned pk2s(float lo, float hi) { return pg8::cvt_pk_bf16(lo, hi); }

__device__ __forceinline__ void retention_phase(LAS unsigned char* lds, const bf16_t* Q, const bf16_t* Kb, const bf16_t* V, bf16_t* RET, float* ssr) {
    const int tid = threadIdx.x, wid = __builtin_amdgcn_readfirstlane(tid >> 6), lane = tid & 63, fr = lane & 15, fq = lane >> 4;
    constexpr int QP = 528, VP = 80, PP = 144;
    constexpr int OFF_Q = 0, OFF_K = 33792, OFF_V = 67584, OFF_VD = 72704, OFF_P = 77824, OFF_ST = 87040, ST_BYTES = 16896;
    const unsigned lbase = (unsigned)(size_t)lds;
    const int trq = fr >> 2, trp = fr & 3;
    for (int item = blockIdx.x; item < 256; item += gridDim.x) {
        const int xcd = item & 7, loc = item >> 3, bh = xcd * 4 + (loc >> 3), js = loc & 7, b = bh >> 2, h = bh & 3;
        const float lg = log2f(1.0f - exp2f(-5.0f - (float)h));
        const float cdec = __builtin_amdgcn_exp2f(lg * 64.0f);
        __syncthreads();
        for (int i = tid; i < ST_BYTES / 4; i += 512) ((LAS unsigned*)(lds + OFF_ST))[i] = 0u;
        f32x4 sacc[2][2];
#pragma unroll
        for (int a = 0; a < 2; ++a)
#pragma unroll
            for (int c = 0; c < 2; ++c) sacc[a][c] = (f32x4){0.f, 0.f, 0.f, 0.f};
        const size_t tok0 = (size_t)b * SEQ;
        u32x4 rq[4], rk[4], rv;
#define RET_LOAD(c) do { _Pragma("unroll") for (int _i = 0; _i < 4; ++_i) { const int pc = tid + 512 * _i, row = pc >> 5, ch = pc & 31; const size_t e = (tok0 + 64 * (c) + row) * DM + h * 256 + ch * 8; \
            rq[_i] = *(const u32x4*)(Q + e); rk[_i] = *(const u32x4*)(Kb + e); } \
            if (tid < 256) { const int row = tid >> 2, ch = tid & 3; rv = *(const u32x4*)(V + (tok0 + 64 * (c) + row) * DM + h * 256 + js * 32 + ch * 8); } } while (0)
        RET_LOAD(0);
        for (int c = 0; c < 64; ++c) {
            __syncthreads();
#pragma unroll
            for (int i = 0; i < 4; ++i) { const int pc = tid + 512 * i, row = pc >> 5, ch = pc & 31;
                *(LAS u32x4*)(lds + OFF_Q + row * QP + ch * 16) = rq[i]; *(LAS u32x4*)(lds + OFF_K + row * QP + ch * 16) = rk[i]; }
            if (tid < 256) { const int row = tid >> 2, ch = tid & 3; *(LAS u32x4*)(lds + OFF_V + row * VP + ch * 16) = rv;
                const float kd = __builtin_amdgcn_exp2f(lg * (float)(63 - row)); f32x4 a0, a1; unpack8(rv, a0, a1); a0 *= kd; a1 *= kd;
                u32x4 w; w.x = pk2s(a0[0], a0[1]); w.y = pk2s(a0[2], a0[3]); w.z = pk2s(a1[0], a1[1]); w.w = pk2s(a1[2], a1[3]);
                *(LAS u32x4*)(lds + OFF_VD + row * VP + ch * 16) = w; }
            if (c + 1 < 64) RET_LOAD(c + 1);
            __syncthreads();
            bf16x8 qfc[8];
            {
                const int r = wid >> 1, kb0 = 2 * (wid & 1);
                f32x4 sT[2] = {(f32x4){0.f, 0.f, 0.f, 0.f}, (f32x4){0.f, 0.f, 0.f, 0.f}};
#pragma unroll
                for (int ks = 0; ks < 8; ++ks) {
                    const bf16x8 qf = *(const LAS bf16x8*)(lds + OFF_Q + (16 * r + fr) * QP + (32 * ks + 8 * fq) * 2); qfc[ks] = qf;
#pragma unroll
                    for (int j = 0; j < 2; ++j) { const bf16x8 kf = *(const LAS bf16x8*)(lds + OFF_K + (16 * (kb0 + j) + fr) * QP + (32 * ks + 8 * fq) * 2);
                        sT[j] = __builtin_amdgcn_mfma_f32_16x16x32_bf16(kf, qf, sT[j], 0, 0, 0); }
                }
                const int n = 16 * r + fr;
#pragma unroll
                for (int j = 0; j < 2; ++j) { const int m0 = 16 * (kb0 + j) + 4 * fq; float pv[4];
#pragma unroll
                    for (int i = 0; i < 4; ++i) { const int d = n - (m0 + i); pv[i] = sT[j][i] * __builtin_amdgcn_exp2f(lg * (float)(d < 0 ? -d : d)); }
                    u32x2 w; w.x = pk2s(pv[0], pv[1]); w.y = pk2s(pv[2], pv[3]);
                    *(LAS u32x2*)(lds + OFF_P + n * PP + m0 * 2) = w; }
            }
            {
#pragma unroll
                for (int a = 0; a < 2; ++a)
#pragma unroll
                    for (int cc = 0; cc < 2; ++cc) sacc[a][cc] *= cdec;
                {
                    const int r0 = 8 * fq + trq;
                    s16x4 ta[2][4], tb[2][4];
#pragma unroll
                    for (int a = 0; a < 2; ++a) tr4<0, 4 * QP, 32 * QP, 36 * QP>(lbase + OFF_K + r0 * QP + (16 * (2 * wid + a) + 4 * trp) * 2, ta[a][0], ta[a][1], ta[a][2], ta[a][3]);
#pragma unroll
                    for (int cc = 0; cc < 2; ++cc) tr4<0, 4 * VP, 32 * VP, 36 * VP>(lbase + OFF_VD + r0 * VP + (16 * cc + 4 * trp) * 2, tb[cc][0], tb[cc][1], tb[cc][2], tb[cc][3]);
                    tr_wait4(ta[0][0], ta[0][1], ta[0][2], ta[0][3]); tr_wait4(ta[1][0], ta[1][1], ta[1][2], ta[1][3]);
                    tr_wait4(tb[0][0], tb[0][1], tb[0][2], tb[0][3]); tr_wait4(tb[1][0], tb[1][1], tb[1][2], tb[1][3]);
#pragma unroll
                    for (int ks = 0; ks < 2; ++ks)
#pragma unroll
                        for (int a = 0; a < 2; ++a)
#pragma unroll
                            for (int cc = 0; cc < 2; ++cc) sacc[a][cc] = __builtin_amdgcn_mfma_f32_16x16x32_bf16(cat8(ta[a][2 * ks], ta[a][2 * ks + 1]), cat8(tb[cc][2 * ks], tb[cc][2 * ks + 1]), sacc[a][cc], 0, 0, 0);
                }
                LAS unsigned char* stn = lds + OFF_ST + ((c + 1) & 1) * ST_BYTES;
#pragma unroll
                for (int a = 0; a < 2; ++a)
#pragma unroll
                    for (int cc = 0; cc < 2; ++cc) { u32x2 w; w.x = pk2s(sacc[a][cc][0], sacc[a][cc][1]); w.y = pk2s(sacc[a][cc][2], sacc[a][cc][3]);
                        *(LAS u32x2*)(stn + (16 * cc + fr) * QP + (16 * (2 * wid + a) + 4 * fq) * 2) = w; }
            }
            __syncthreads();
            {
                const int r = wid >> 1, cb = wid & 1;
                f32x4 ain = (f32x4){0.f, 0.f, 0.f, 0.f}, acr = (f32x4){0.f, 0.f, 0.f, 0.f};
                {
                    s16x4 tv[4];
                    tr4<0, 4 * VP, 32 * VP, 36 * VP>(lbase + OFF_V + (8 * fq + trq) * VP + (16 * cb + 4 * trp) * 2, tv[0], tv[1], tv[2], tv[3]);
                    bf16x8 pf[2];
#pragma unroll
                    for (int ks = 0; ks < 2; ++ks) pf[ks] = *(const LAS bf16x8*)(lds + OFF_P + (16 * r + fr) * PP + (32 * ks + 8 * fq) * 2);
                    tr_wait4(tv[0], tv[1], tv[2], tv[3]);
#pragma unroll
                    for (int ks = 0; ks < 2; ++ks) ain = __builtin_amdgcn_mfma_f32_16x16x32_bf16(cat8(tv[2 * ks], tv[2 * ks + 1]), pf[ks], ain, 0, 0, 0);
                }
                const LAS unsigned char* stc = lds + OFF_ST + (c & 1) * ST_BYTES;
#pragma unroll
                for (int ks = 0; ks < 8; ++ks) {
                    const bf16x8 qf = qfc[ks];
                    const bf16x8 sf = *(const LAS bf16x8*)(stc + (16 * cb + fr) * QP + (32 * ks + 8 * fq) * 2);
                    acr = __builtin_amdgcn_mfma_f32_16x16x32_bf16(sf, qf, acr, 0, 0, 0);
                }
                const int n = 16 * r + fr; const float qd = __builtin_amdgcn_exp2f(lg * (float)(n + 1));
                const f32x4 o = ain + acr * qd;
                const size_t t = tok0 + 64 * c + n;
                u32x2 w; w.x = pk2s(o[0], o[1]); w.y = pk2s(o[2], o[3]);
                *(u32x2*)(RET + t * DM + h * 256 + js * 32 + cb * 16 + 4 * fq) = w;
                float q = (o[0] * o[0] + o[1] * o[1]) + (o[2] * o[2] + o[3] * o[3]);
                q += __shfl_xor(q, 16); q += __shfl_xor(q, 32);
                if (fq == 0) atomicAdd(ssr + t * 4 + h, q);
            }
        }
#undef RET_LOAD
    }
}

__device__ __forceinline__ void mix_elementwise(const bf16_t* RET, bf16_t* RN, const bf16_t* GR, const float* ssr, const bf16_t* P, bf16_t* PL) {
    const int gt = blockIdx.x * 512 + threadIdx.x, NGT = gridDim.x * 512;
    constexpr int T = 32;
    for (int item = gt; item < 128 * (MTOK / T); item += NGT) {
        const int ch = item & 127, g = ch >> 5, w = 2 << g; const size_t t0 = (size_t)(item >> 7) * T; const int pos0 = (int)(t0 & (SEQ - 1));
        const size_t base = t0 * DM + ch * 8;
        f32x4 s0 = (f32x4){0.f, 0.f, 0.f, 0.f}, s1 = s0;
        for (int k = 1; k < w; ++k) if (pos0 - k >= 0) { f32x4 b0, b1; unpack8(*(const u32x4*)(P + base - (size_t)k * DM), b0, b1); s0 += b0; s1 += b1; }
        u32x4 pc = *(const u32x4*)(P + base), rc = *(const u32x4*)(RET + base), gc = *(const u32x4*)(GR + base), oc = (u32x4){0u, 0u, 0u, 0u};
        float sq = ssr[t0 * 4 + g];
        if (pos0 + 1 >= w) oc = *(const u32x4*)(P + base - (size_t)(w - 1) * DM);
        for (int j = 0; j < T; ++j) {
            const size_t off = base + (size_t)j * DM; const int pos = pos0 + j;
            const u32x4 pcur = pc, rcur = rc, gcur = gc, ocur = oc; const float sqc = sq;
            if (j + 1 < T) { pc = *(const u32x4*)(P + off + DM); rc = *(const u32x4*)(RET + off + DM); gc = *(const u32x4*)(GR + off + DM); sq = ssr[(t0 + j + 1) * 4 + g];
                if (pos + 2 >= w) oc = *(const u32x4*)(P + off + DM - (size_t)(w - 1) * DM); }
            f32x4 c0, c1; unpack8(pcur, c0, c1); s0 += c0; s1 += c1;
            const int cnt = (pos + 1) < w ? (pos + 1) : w; const float inv = 1.0f / (float)cnt;
            *(u32x4*)(PL + off) = pack8(s0 * inv - c0, s1 * inv - c1);
            if (pos + 1 >= w) { f32x4 o0, o1; unpack8(ocur, o0, o1); s0 -= o0; s1 -= o1; }
            const float rs = __builtin_amdgcn_rsqf(sqc * (1.0f / 256.0f) + EPS);
            f32x4 a0, a1, g0, g1; unpack8(rcur, a0, a1); unpack8(gcur, g0, g1);
            *(u32x4*)(RN + off) = pack8(a0 * rs * g0, a1 * rs * g1);
        }
    }
}

__device__ __forceinline__ void final_norm(const bf16_t* hin, float* out, const float* ss, const float* g) {
    const size_t gt = (size_t)blockIdx.x * 512 + threadIdx.x, NGT = (size_t)gridDim.x * 512, NI = (size_t)MTOK * 128;
    u32x4 hn = (u32x4){0u, 0u, 0u, 0u}; float sn = 1.f;
    if (gt < NI) { hn = *(const u32x4*)(hin + (gt >> 7) * DM + (gt & 127) * 8); sn = ss[gt >> 7]; }
    for (size_t i = gt; i < NI; i += NGT) {
        const size_t t = i >> 7; const int c8 = (int)(i & 127) * 8; const u32x4 hc = hn; const float rs = rs_of(sn);
        const size_t i2 = i + NGT;
        if (i2 < NI) { hn = *(const u32x4*)(hin + (i2 >> 7) * DM + (i2 & 127) * 8); sn = ss[i2 >> 7]; }
        f32x4 v0, v1; unpack8(hc, v0, v1);
        const f32x4 g0 = *(const f32x4*)(g + c8), g1 = *(const f32x4*)(g + c8 + 4);
        *(f32x4*)(out + t * DM + c8) = v0 * rs * g0; *(f32x4*)(out + t * DM + c8 + 4) = v1 * rs * g1;
    }
}

#define XB_TMO      128
#define XB_XCNT(j)  (256  + 64 * (j))
#define XB_XSUB(j)  (1280 + 64 * (j))
#define XB_XGEN(j)  (2304 + 64 * (j))
#define XB_TOP      3328
#define XB_TOPGEN   3392
#define XCD_BAR_WORDS 3456
#define XB_SPIN_CAP (1u << 18)
__device__ __forceinline__ unsigned xb_ld(unsigned* p)              { return __hip_atomic_load(p, __ATOMIC_RELAXED, __HIP_MEMORY_SCOPE_AGENT); }
__device__ __forceinline__ unsigned xb_add(unsigned* p, unsigned v) { return __hip_atomic_fetch_add(p, v, __ATOMIC_RELAXED, __HIP_MEMORY_SCOPE_AGENT); }
__device__ __forceinline__ unsigned xb_xcc_id() { return (unsigned)__builtin_amdgcn_s_getreg((3 << 11) | 20) & 0xFu; }
#define XB_SPIN(cond, bar) do { unsigned _sp = 0; while (cond) { __builtin_amdgcn_s_sleep(1); \
    if ((++_sp & 255u) == 0u) { if (xb_ld(&(bar)[XB_TMO])) break; if (_sp > XB_SPIN_CAP) { atomicAdd(&(bar)[XB_TMO], 1u); break; } } } } while (0)
struct XcdBarrier { unsigned* bar; unsigned x; volatile LAS unsigned* st; };
__device__ __forceinline__ XcdBarrier xcd_barrier_post(unsigned* bar, volatile LAS unsigned* st) {
    XcdBarrier b; b.bar = bar; b.x = xb_xcc_id(); b.st = st;
    if (threadIdx.x == 0) (void)xb_add(&bar[XB_XCNT(b.x)], 1u);
    return b;
}
__device__ __forceinline__ void xcd_barrier_complete(unsigned* bar, unsigned x, unsigned& nloc, unsigned& nx) {
    const unsigned G = gridDim.x * gridDim.y * gridDim.z;
    unsigned sum, cnt, mine, sp = 0u;
    for (;;) {
        sum = 0u; cnt = 0u; mine = 0u;
#pragma unroll
        for (unsigned j = 0; j < 16; ++j) { const unsigned c = xb_ld(&bar[XB_XCNT(j)]); sum += c; cnt += (c > 0u) ? 1u : 0u; mine = (j == x) ? c : mine; }
        if (sum == G) break;
        __builtin_amdgcn_s_sleep(1);
        if ((++sp & 255u) == 0u) { if (xb_ld(&bar[XB_TMO])) break; if (sp > XB_SPIN_CAP) { atomicAdd(&bar[XB_TMO], 1u); break; } }
    }
    nloc = mine > 0u ? mine : 1u; nx = cnt > 0u ? cnt : 1u;
}
__device__ __forceinline__ void xcd_barrier(const XcdBarrier& b) {
    asm volatile("s_waitcnt vmcnt(0)" ::: "memory");
    __syncthreads();
    if (threadIdx.x == 0) {
        unsigned* bar = b.bar;
        __builtin_amdgcn_s_waitcnt(0);
        unsigned nloc = b.st[0], nx = b.st[1];
        if (nloc == 0u) { xcd_barrier_complete(bar, b.x, nloc, nx); b.st[0] = nloc; b.st[1] = nx; }
        const unsigned old = xb_add(&bar[XB_XSUB(b.x)], 1u);
        const unsigned gen = old / nloc;
        if (old + 1u == (gen + 1u) * nloc) {
            __builtin_amdgcn_fence(__ATOMIC_RELEASE, "agent");
            asm volatile("s_waitcnt vmcnt(0)" ::: "memory");
            const unsigned og = xb_add(&bar[XB_TOP], 1u);
            const unsigned tg = og / nx;
            if (og + 1u == (tg + 1u) * nx) xb_add(&bar[XB_TOPGEN], 1u);
            else XB_SPIN(xb_ld(&bar[XB_TOPGEN]) == tg, bar);
            __builtin_amdgcn_fence(__ATOMIC_ACQUIRE, "agent");
            xb_add(&bar[XB_XGEN(b.x)], 1u);
            asm volatile("s_waitcnt vmcnt(0)" ::: "memory");
        } else {
            XB_SPIN(xb_ld(&bar[XB_XGEN(b.x)]) == gen, bar);
            __builtin_amdgcn_fence(__ATOMIC_ACQUIRE, "agent");
            asm volatile("s_waitcnt vmcnt(0)" ::: "memory");
        }
    }
    __syncthreads();
}
constexpr size_t WS_BAR = 62 * MiB;

constexpr int NPHASE = 13;
__global__ void __launch_bounds__(512, 2) fwd_megakernel(Params p) {
    extern __shared__ __attribute__((aligned(16))) unsigned char lds_raw[];
    LAS unsigned char* lds = (LAS unsigned char*)lds_raw;
    unsigned char* ws = p.ws;
    const int G = gridDim.x, c = blockIdx.x;
    bf16_t* S0 = (bf16_t*)(ws + WS_S0); bf16_t* S1 = (bf16_t*)(ws + WS_S1); bf16_t* BIG = (bf16_t*)(ws + WS_BIG);
    bf16_t* B0 = BIG; bf16_t* B1 = BIG + SLOT / 2; bf16_t* B2 = BIG + SLOT; bf16_t* B3 = BIG + 3 * (SLOT / 2);
    float* ss1 = (float*)(ws + WS_SS1); float* ss2 = (float*)(ws + WS_SS2); float* ss3 = (float*)(ws + WS_SS3); float* ss4 = (float*)(ws + WS_SS4); float* ssr = (float*)(ws + WS_SSR);
    const int lo = p.ph_lo, hi = p.ph_hi;
    volatile LAS unsigned* xst = (volatile LAS unsigned*)(lds + pg8::STAGE_BYTES);
    if (threadIdx.x < 4) xst[threadIdx.x] = 0u;
    __syncthreads();
    XcdBarrier xbar = xcd_barrier_post((unsigned*)(ws + WS_BAR), xst);
    bf16_t* OLO = (bf16_t*)p.out; bf16_t* OHI = (bf16_t*)p.out + SLOT / 2;
#ifndef ENMASK
#define ENMASK 0x1fff
#endif
#define IN(k) (((ENMASK >> (k)) & 1) && lo <= (k) && (k) < hi)
#define SEAM(k) do { if (IN(k) && IN((k) + 1)) { if ((k) == 0) cg::this_grid().sync(); else xcd_barrier(xbar); } } while (0)
#ifndef REPMASK
#define REPMASK 0
#endif
#define NREP(k) (((REPMASK >> (k)) & 1) ? 2 : 1)
    float* dss = (float*)(ws + 60 * MiB); bf16_t* DUMB = (bf16_t*)(ws + 448 * MiB);
    if (IN(0)) for (int rep = NREP(0); rep > 0; --rep) p0_prologue(p, lds);
    SEAM(0);
    if (IN(1)) {
        pg8::Gemm g{S0, (const bf16_t*)(ws + WS_W1A), DM, DM, DM, 0}; pg8::StaticOrder S; S.init(MTOK, 2 * DFF, G, c, NREP(1));
        EpiSwiglu E{BIG, ss1}; pg8::gemm_phase(lds, g, S, E);
    }
    SEAM(1);
    if (IN(2)) {
        pg8::Gemm g{BIG, (const bf16_t*)(ws + WS_W1B), DFF, DFF, DFF, 0}; pg8::StaticOrder S; S.init(MTOK, DM, G, c, NREP(2));
        EpiResid<true> E{p.in[0], OLO, ss2, 0.5f, DUMB, dss}; pg8::gemm_phase(lds, g, S, E);
    }
    SEAM(2);
    bf16_t* S7 = (bf16_t*)(ws + 448 * MiB);
    if (IN(3)) {
#define RUN_QKV() do { pg8::Gemm g{OLO, (const bf16_t*)(ws + WS_WIN), DM, DM, DM, 0}; pg8::StaticOrder S; S.init(MTOK, 3072, G, c, NREP(3)); \
            EpiQKV E{BIG, ss2, (const float*)(ws + WS_COS), (const float*)(ws + WS_SIN)}; pg8::gemm_phase(lds, g, S, E); } while (0)
#define RUN_GATES() do { pg8::Gemm g{OLO, (const bf16_t*)(ws + WS_WIN) + (size_t)3072 * DM, DM, DM, DM, 0}; pg8::StaticOrder S; S.init(MTOK, 4096, G, c, NREP(5)); \
            EpiGates E{ws, OHI, ss2, p.in[6]}; pg8::gemm_phase(lds, g, S, E); } while (0)
        if ((c >> 3) & 1) { RUN_GATES(); RUN_QKV(); } else { RUN_QKV(); RUN_GATES(); }
#undef RUN_QKV
#undef RUN_GATES
    }
    SEAM(3);
    if (IN(4)) for (int rep = NREP(4); rep > 0; --rep) retention_phase(lds, B0, B1, B2, S0, rep > 1 ? dss : ssr);
    SEAM(4);
    if (IN(6)) for (int rep = NREP(6); rep > 0; --rep) mix_elementwise(S0, B0, B3, ssr, S1, B1);
    if (IN(5) && IN(6) && IN(7)) xcd_barrier(xbar);
    if (IN(7)) {
        {
            pg8::Gemm g{B1, (const bf16_t*)(ws + WS_WPL), DM, 256, 256, 256}; pg8::StaticOrder S; S.init(MTOK, DM, G, c, NREP(7));
            EpiScaleCol E{B2, p.in[8]}; pg8::gemm_phase(lds, g, S, E);
        }
        {
            pg8::Gemm g{B0, (const bf16_t*)(ws + WS_WRU), DM, DM, DM, 0}; pg8::StaticOrder S; S.init(MTOK, DM, G, c, NREP(7));
            EpiGateMul<false> E{S0, S7, nullptr}; pg8::gemm_phase(lds, g, S, E);
        }
    }
    SEAM(7);
    if (IN(8)) {
        pg8::Gemm g{B2, (const bf16_t*)(ws + WS_WPU), DM, DM, DM, 0}; pg8::StaticOrder S; S.init(MTOK, DM, G, c, NREP(8));
        EpiGateMul<true> E{S1, OHI, S0}; pg8::gemm_phase(lds, g, S, E);
    }
    SEAM(8);
    if (IN(9)) {
        pg8::Gemm g{S1, (const bf16_t*)(ws + WS_WO), DM, DM, DM, 0}; pg8::StaticOrder S; S.init(MTOK, DM, G, c, NREP(9));
        EpiResid<false> E{OLO, OHI, ss3, 1.0f, DUMB, dss}; pg8::gemm_phase(lds, g, S, E);
    }
    SEAM(9);
    if (IN(10)) {
        pg8::Gemm g{OHI, (const bf16_t*)(ws + WS_W2A), DM, DM, DM, 0}; pg8::StaticOrder S; S.init(MTOK, 2 * DFF, G, c, NREP(10));
        EpiSwiglu E{BIG, ss3}; pg8::gemm_phase(lds, g, S, E);
    }
    SEAM(10);
    if (IN(11)) {
        pg8::Gemm g{BIG, (const bf16_t*)(ws + WS_W2B), DFF, DFF, DFF, 0}; pg8::StaticOrder S; S.init(MTOK, DM, G, c, NREP(11));
        EpiResid<false> E{OHI, S1, ss4, 0.5f, DUMB, dss}; pg8::gemm_phase(lds, g, S, E);
    }
    SEAM(11);
    if (IN(12)) for (int rep = NREP(12); rep > 0; --rep) final_norm(S1, rep > 1 ? (float*)BIG : p.out, ss4, p.in[15]);
#undef IN
#undef SEAM
}

extern "C" void kernel_launch(void* const* d_in, const int* in_sizes, int n_in, void* d_out, int out_size, void* d_ws, size_t ws_size, hipStream_t stream) {
    constexpr int LDS_BYTES = pg8::STAGE_BYTES + 16;
    static int grid = 0;
    if (grid == 0) {
        if (n_in != 16 || out_size != MTOK * DM || ws_size < WS_END) { fprintf(stderr, "kernel_launch: unexpected shapes (n_in %d out %d ws %zu)\n", n_in, out_size, ws_size); grid = -1; return; }
        int dev = 0, cus = 0, per_cu = 0;
        (void)hipGetDevice(&dev); (void)hipDeviceGetAttribute(&cus, hipDeviceAttributeMultiprocessorCount, dev);
        if (hipFuncSetAttribute((const void*)fwd_megakernel, hipFuncAttributeMaxDynamicSharedMemorySize, LDS_BYTES) != hipSuccess) { fprintf(stderr, "kernel_launch: hipFuncSetAttribute failed\n"); grid = -1; return; }
        if (hipOccupancyMaxActiveBlocksPerMultiprocessor(&per_cu, (const void*)fwd_megakernel, 512, LDS_BYTES) != hipSuccess || per_cu < 1) { fprintf(stderr, "kernel_launch: occupancy query gave %d\n", per_cu); per_cu = 1; }
        (void)hipGetLastError();
        grid = cus;
    }
    if (grid < 0) return;
    if (hipMemsetAsync((char*)d_ws + WS_BAR, 0, XCD_BAR_WORDS * 4, stream) != hipSuccess) { fprintf(stderr, "kernel_launch: memset failed\n"); return; }
    Params p{};
    for (int i = 0; i < 16; ++i) p.in[i] = (const float*)d_in[i];
    p.out = (float*)d_out; p.ws = (unsigned char*)d_ws;
#if N_LAUNCH_MODE == 1
    p.ph_lo = 0; p.ph_hi = NPHASE;
    void* args[] = {&p};
    hipError_t e = hipLaunchCooperativeKernel((const void*)fwd_megakernel, dim3(grid), dim3(512), args, LDS_BYTES, stream);
    if (e != hipSuccess) fprintf(stderr, "cooperative launch failed: %s (grid %d)\n", hipGetErrorString(e), grid);
#else
    for (int ph = 0; ph < NPHASE; ++ph) { p.ph_lo = ph; p.ph_hi = ph + 1; hipLaunchKernelGGL(fwd_megakernel, dim3(grid), dim3(512), LDS_BYTES, stream, p); }
#endif
}
```

```cpp
#include <hip/hip_runtime.h>
#include <hip/hip_cooperative_groups.h>
#include <cstdio>
namespace cg = cooperative_groups;

#ifndef N_LAUNCH_MODE
#define N_LAUNCH_MODE 1
#endif

#define LAS __attribute__((address_space(3)))
typedef unsigned short bf16_t;
typedef short bf16x8 __attribute__((ext_vector_type(8)));
typedef short s16x4 __attribute__((ext_vector_type(4)));
typedef float f32x4 __attribute__((ext_vector_type(4)));
typedef unsigned u32x4 __attribute__((ext_vector_type(4)));
typedef unsigned u32x2 __attribute__((ext_vector_type(2)));

constexpr int MTOK = 32768, DM = 1024, DFF = 2816, SEQ = 4096, NIN = 7168;
constexpr float EPS = 1e-6f;

constexpr size_t MiB = 1024ull * 1024ull;
constexpr size_t WS_W1A = 0;
constexpr size_t WS_W1B = WS_W1A + 5632ull * 1024 * 2;
constexpr size_t WS_WIN = WS_W1B + 1024ull * 2816 * 2;
constexpr size_t WS_WPL = WS_WIN + 7168ull * 1024 * 2;
constexpr size_t WS_WRU = WS_WPL + 1024ull * 256 * 2;
constexpr size_t WS_WPU = WS_WRU + 1024ull * 1024 * 2;
constexpr size_t WS_WO  = WS_WPU + 1024ull * 1024 * 2;
constexpr size_t WS_W2A = WS_WO + 1024ull * 1024 * 2;
constexpr size_t WS_W2B = WS_W2A + 5632ull * 1024 * 2;
constexpr size_t WS_COS = WS_W2B + 1024ull * 2816 * 2;
constexpr size_t WS_SIN = WS_COS + 4096ull * 128 * 4;
constexpr size_t WS_SS1 = WS_SIN + 4096ull * 128 * 4;
constexpr size_t WS_SS2 = WS_SS1 + MTOK * 4ull;
constexpr size_t WS_SS3 = WS_SS2 + MTOK * 4ull;
constexpr size_t WS_SS4 = WS_SS3 + MTOK * 4ull;
constexpr size_t WS_SSR = WS_SS4 + MTOK * 4ull;
constexpr size_t WS_SMALL_END = WS_SSR + MTOK * 16ull;
static_assert(WS_SMALL_END <= 64 * MiB, "weights region");
constexpr size_t WS_S0 = 64 * MiB;
constexpr size_t WS_S1 = 128 * MiB;
constexpr size_t WS_BIG = 192 * MiB;
constexpr size_t WS_END = 512 * MiB;
constexpr size_t SLOT = 64 * MiB;

namespace pg8 {
constexpr int BM = 256, BK = 64, HALF = 128, HTB = HALF * BK * 2, STAGE_BYTES = 8 * HTB, NXCD = 8, WGM = 8;
__host__ __device__ __forceinline__ int lds_byte(int r, int c) { const int st = (r >> 4) * 2 + (c >> 5), rr = r & 15, cc = c & 31, ob = rr * 64 + cc * 2; return st * 1024 + (ob ^ (((ob >> 9) & 1) << 5)); }
__host__ __device__ __forceinline__ void stage_rc(int b, int& R, int& C) { const int st = b / 1024, sb = b % 1024, swz = sb ^ (((sb >> 9) & 1) << 5); R = (st >> 1) * 16 + swz / 64; C = (st & 1) * 32 + (swz % 64) / 2; }
__host__ __device__ __forceinline__ int perm32(int rho) { const int n = rho >> 4, i = rho & 15; return 8 * (i >> 2) + 4 * n + (i & 3); }

struct Unit { int pm, pn, pass; };
struct Gemm { const bf16_t* A; const bf16_t* Bt; int lda, ldb, K; int a_pn_off; };

struct StaticOrder {
    int nM, nN, nwg, G, c, rept;
    __host__ __device__ void init(int M, int N, int G_, int c_, int rept_ = 1) { nM = M / BM; nN = N / BM; nwg = nM * nN; G = G_; c = c_; rept = rept_; }
    __host__ __device__ bool next(int i, Unit& u) const {
        u.pass = 0;
        if (rept > 1) { const int ni = (nwg - c + G - 1) / G; if (ni <= 0 || i >= ni * rept) return false; u.pass = rept - 1 - i / ni; i = i % ni; }
        const long L = (long)i * G + c; if (L >= nwg) return false;
        int wgid = (int)L; { const int q = nwg / NXCD, r = nwg % NXCD, xcd = wgid % NXCD, off = wgid / NXCD; wgid = (xcd < r ? xcd * (q + 1) : r * (q + 1) + (xcd - r) * q) + off; }
        const int nig = WGM * nN, gid = wgid / nig, fm = gid * WGM, gsz = (nM - fm) < WGM ? (nM - fm) : WGM;
        u.pm = fm + ((wgid % nig) % gsz); u.pn = (wgid % nig) / gsz; return true;
    }
};
typedef float f32x2_t __attribute__((ext_vector_type(2)));
typedef __bf16 bf16x2_t __attribute__((ext_vector_type(2)));
__device__ __forceinline__ unsigned cvt_pk_bf16(float lo, float hi) { f32x2_t v = {lo, hi}; bf16x2_t b = __builtin_convertvector(v, bf16x2_t); return __builtin_bit_cast(unsigned, b); }

template <class Epi>
__device__ __forceinline__ void gemm_phase(LAS unsigned char* lds, const Gemm g, const StaticOrder& S, const Epi& E) {
    const int tid = threadIdx.x, wid = __builtin_amdgcn_readfirstlane(tid >> 6), lane = tid & 63, wr = wid >> 2, wc = wid & 3, fr = lane & 15, fq = lane >> 4;
    const int K = g.K, nt = K / BK;
    unsigned voffA[2], voffB[2];
#pragma unroll
    for (int i = 0; i < 2; ++i) { int R, C; stage_rc(tid * 16 + i * 8192, R, C); const int Rb = Epi::PERM ? ((R & ~31) + perm32(R & 31)) : R;
        voffA[i] = (unsigned)(R * g.lda + C) * 2u; voffB[i] = (unsigned)(Rb * g.ldb + C) * 2u; }
    const size_t kstep = (size_t)(BK * 2);
    const size_t hstepA = (size_t)HALF * g.lda * 2, hstepB = (size_t)HALF * g.ldb * 2;
    const size_t tstepA = 2 * hstepA, tstepB = 2 * hstepB;
    const unsigned ldsw = (unsigned)wid * 1024u;
    const int aoff = lds_byte(wr * 64 + fr, fq * 8), boff = lds_byte(wc * 32 + fr, fq * 8);
#define PG8_SA(b, h) (((b) * 2 + (h)) * HTB)
#define PG8_SB(b, h) ((4 + (b) * 2 + (h)) * HTB)
#define PG8_STAGE(bufoff, gbase, voff) do { _Pragma("unroll") for (int _i = 0; _i < 2; ++_i) \
        __builtin_amdgcn_global_load_lds((const unsigned*)((const char*)(gbase) + (voff)[_i]), (LAS unsigned*)(lds + (bufoff) + ldsw + _i * 8192), 16, 0, 0); } while (0)
#define PG8_LDA(dst, b, h) do { _Pragma("unroll") for (int m = 0; m < 4; ++m) _Pragma("unroll") for (int k = 0; k < 2; ++k) dst[m][k] = *(const LAS bf16x8*)(lds + PG8_SA(b, h) + aoff + m * 2048 + k * 1024); } while (0)
#define PG8_LDB(dst, b, h) do { _Pragma("unroll") for (int n = 0; n < 2; ++n) _Pragma("unroll") for (int k = 0; k < 2; ++k) dst[n][k] = *(const LAS bf16x8*)(lds + PG8_SB(b, h) + boff + n * 2048 + k * 1024); } while (0)
#define PG8_MMA(ai, bj, At, Bt) do { __builtin_amdgcn_s_setprio(1); _Pragma("unroll") for (int m = 0; m < 4; ++m) _Pragma("unroll") for (int n = 0; n < 2; ++n) _Pragma("unroll") for (int k = 0; k < 2; ++k) \
        acc[ai][bj][m][n] = __builtin_amdgcn_mfma_f32_16x16x32_bf16(Bt[n][k], At[m][k], acc[ai][bj][m][n], 0, 0, 0); __builtin_amdgcn_s_setprio(0); } while (0)
#define PG8_WAIT_V(n) asm volatile("s_waitcnt vmcnt(" #n ")" ::: "memory")
#define PG8_WAIT_L(n) asm volatile("s_waitcnt lgkmcnt(" #n ")" ::: "memory")
#define PG8_BAR __builtin_amdgcn_s_barrier()
#define PG8_SCHED __builtin_amdgcn_sched_barrier(0)
    Unit cur, nxt; int ui = 0;
    if (!S.next(0, cur)) return;
    typename Epi::Pre pre;
    f32x4 acc[2][2][4][2];
#pragma unroll
    for (int a = 0; a < 2; ++a)
#pragma unroll
        for (int b = 0; b < 2; ++b)
#pragma unroll
            for (int m = 0; m < 4; ++m)
#pragma unroll
                for (int n = 0; n < 2; ++n) acc[a][b][m][n] = (f32x4){0.f, 0.f, 0.f, 0.f};
    bf16x8 At[4][2], B0[2][2], B1[2][2];
    const char* cA = (const char*)g.A + (size_t)cur.pm * tstepA + (size_t)cur.pn * g.a_pn_off * 2; const char* cB = (const char*)g.Bt + (size_t)cur.pn * tstepB;
    PG8_STAGE(PG8_SB(0, 0), cB, voffB); PG8_STAGE(PG8_SB(0, 1), cB + hstepB, voffB); PG8_STAGE(PG8_SA(0, 0), cA, voffA); PG8_STAGE(PG8_SA(0, 1), cA + hstepA, voffA);
    if (wr == 1) PG8_BAR;
    PG8_WAIT_V(2); PG8_BAR;
    PG8_STAGE(PG8_SB(1, 0), cB + kstep, voffB); PG8_STAGE(PG8_SA(1, 0), cA + kstep, voffA); PG8_STAGE(PG8_SB(1, 1), cB + hstepB + kstep, voffB);
    PG8_WAIT_V(6); PG8_BAR;
    for (;;) {
        const bool has_next = S.next(ui + 1, nxt);
        const char* nA = has_next ? (const char*)g.A + (size_t)nxt.pm * tstepA + (size_t)nxt.pn * g.a_pn_off * 2 : cA; const char* nB = has_next ? (const char*)g.Bt + (size_t)nxt.pn * tstepB : cB;
#pragma unroll 1
        for (int t = 0; t < nt; t += 2) {
            const bool last = (t == nt - 2);
            const char* a1 = cA + (size_t)(t + 1) * kstep;
            const char* a2 = last ? nA : cA + (size_t)(t + 2) * kstep; const char* b2 = last ? nB : cB + (size_t)(t + 2) * kstep;
            const char* a3 = a2 + kstep; const char* b3 = b2 + kstep;
            if (last) E.prefetch(pre, cur, wr, wc, fr, fq);
            PG8_LDB(B0, 0, 0); PG8_LDB(B1, 0, 1); PG8_SCHED; PG8_LDA(At, 0, 0); PG8_STAGE(PG8_SA(1, 1), a1 + hstepA, voffA);
            PG8_WAIT_V(8); PG8_WAIT_L(0); PG8_BAR; PG8_MMA(0, 0, At, B0); PG8_MMA(0, 1, At, B1); PG8_BAR; PG8_SCHED;
            PG8_LDA(At, 0, 1); PG8_STAGE(PG8_SB(0, 0), b2, voffB); PG8_STAGE(PG8_SB(0, 1), b2 + hstepB, voffB); PG8_STAGE(PG8_SA(0, 0), a2, voffA);
            PG8_WAIT_V(8); PG8_WAIT_L(0); PG8_BAR; PG8_MMA(1, 0, At, B0); PG8_MMA(1, 1, At, B1); PG8_BAR; PG8_SCHED;
            PG8_LDB(B0, 1, 0); PG8_LDB(B1, 1, 1); PG8_SCHED; PG8_LDA(At, 1, 0); PG8_STAGE(PG8_SA(0, 1), a2 + hstepA, voffA);
            PG8_WAIT_V(8); PG8_WAIT_L(0); PG8_BAR; PG8_MMA(0, 0, At, B0); PG8_MMA(0, 1, At, B1); PG8_BAR; PG8_SCHED;
            PG8_LDA(At, 1, 1); PG8_STAGE(PG8_SB(1, 0), b3, voffB); PG8_STAGE(PG8_SB(1, 1), b3 + hstepB, voffB); PG8_STAGE(PG8_SA(1, 0), a3, voffA);
            PG8_WAIT_V(8); PG8_WAIT_L(0); PG8_BAR; PG8_MMA(1, 0, At, B0); PG8_MMA(1, 1, At, B1); PG8_BAR; PG8_SCHED;
        }
        if (wr == 0) PG8_BAR;
        E(acc, pre, cur, wr, wc, fr, fq);
        if (wr == 1) PG8_BAR;
        if (!has_next) break;
#pragma unroll
        for (int a = 0; a < 2; ++a)
#pragma unroll
            for (int b = 0; b < 2; ++b)
#pragma unroll
                for (int m = 0; m < 4; ++m)
#pragma unroll
                    for (int n = 0; n < 2; ++n) acc[a][b][m][n] = (f32x4){0.f, 0.f, 0.f, 0.f};
        cur = nxt; cA = nA; cB = nB; ++ui;
    }
    PG8_WAIT_V(0);
    if (wr == 0) PG8_BAR;
    PG8_BAR;
#undef PG8_SA
#undef PG8_SB
#undef PG8_STAGE
#undef PG8_LDA
#undef PG8_LDB
#undef PG8_MMA
#undef PG8_WAIT_V
#undef PG8_WAIT_L
#undef PG8_BAR
#undef PG8_SCHED
}
}
using pg8::cvt_pk_bf16;
using pg8::Unit;

__device__ __forceinline__ float sigm_f(float g) { return __builtin_amdgcn_rcpf(1.0f + __builtin_amdgcn_exp2f(g * -1.4426950408889634f)); }
__device__ __forceinline__ float silu_f(float g) { return g * sigm_f(g); }
__device__ __forceinline__ f32x4 sigm4(const f32x4 g) { const f32x4 a = g * -1.4426950408889634f; f32x4 e; e[0] = __builtin_amdgcn_exp2f(a[0]); e[1] = __builtin_amdgcn_exp2f(a[1]); e[2] = __builtin_amdgcn_exp2f(a[2]); e[3] = __builtin_amdgcn_exp2f(a[3]);
    const f32x4 d = e + 1.0f; f32x4 r; r[0] = __builtin_amdgcn_rcpf(d[0]); r[1] = __builtin_amdgcn_rcpf(d[1]); r[2] = __builtin_amdgcn_rcpf(d[2]); r[3] = __builtin_amdgcn_rcpf(d[3]); return r; }
__device__ __forceinline__ float rs_of(float ss) { return __builtin_amdgcn_rsqf(ss * (1.0f / 1024.0f) + EPS); }
__device__ __forceinline__ float bf2f(unsigned short b) { return __uint_as_float(((unsigned)b) << 16); }
__device__ __forceinline__ u32x4 pack8(const f32x4 a, const f32x4 b) { u32x4 w; w.x = cvt_pk_bf16(a[0], a[1]); w.y = cvt_pk_bf16(a[2], a[3]); w.z = cvt_pk_bf16(b[0], b[1]); w.w = cvt_pk_bf16(b[2], b[3]); return w; }
__device__ __forceinline__ void unpack8(const u32x4 w, f32x4& a, f32x4& b) {
    a[0] = __uint_as_float(w.x << 16); a[1] = __uint_as_float(w.x & 0xffff0000u); a[2] = __uint_as_float(w.y << 16); a[3] = __uint_as_float(w.y & 0xffff0000u);
    b[0] = __uint_as_float(w.z << 16); b[1] = __uint_as_float(w.z & 0xffff0000u); b[2] = __uint_as_float(w.w << 16); b[3] = __uint_as_float(w.w & 0xffff0000u); }

#define ROWOF(ri) (row0 + ((ri) >> 2) * 128 + ((ri) & 3) * 16)
#define ACC(ri, bj, n) acc[(ri) >> 2][bj][(ri) & 3][n]
struct EpiSwiglu {
    static constexpr bool PERM = true;
    struct Pre {};
    __device__ __forceinline__ void prefetch(Pre&, const Unit&, int, int, int, int) const {}
    bf16_t* O; const float* ss;
    __device__ __forceinline__ void operator()(const f32x4 (&acc)[2][2][4][2], Pre& pre, const Unit& u, int wr, int wc, int fr, int fq) const {
        const int row0 = u.pm * 256 + wr * 64 + fr, col0 = u.pn * 128 + wc * 32 + 8 * fq;
        float ssv[8];
#pragma unroll
        for (int ri = 0; ri < 8; ++ri) ssv[ri] = ss[ROWOF(ri)];
#pragma unroll
        for (int ri = 0; ri < 8; ++ri) { const int r = ROWOF(ri); const float rs = rs_of(ssv[ri]);
            f32x4 o[2];
#pragma unroll
            for (int n = 0; n < 2; ++n) { const f32x4 gt = ACC(ri, 0, n) * rs, up = ACC(ri, 1, n) * rs; o[n] = (gt * up) * sigm4(gt); }
            *(u32x4*)(O + (size_t)r * DFF + col0) = pack8(o[0], o[1]); }
    }
};
template <bool IN_F32> struct EpiResid {
    static constexpr bool PERM = true;
    struct Pre {};
    __device__ __forceinline__ void prefetch(Pre&, const Unit&, int, int, int, int) const {}
    const void* hin; bf16_t* hb_; float* ss_; float scale; bf16_t* hb_d; float* ss_d;
    __device__ __forceinline__ void ldrow(size_t off, f32x4 (&b)[2][2]) const {
#pragma unroll
        for (int bj = 0; bj < 2; ++bj) {
            if (IN_F32) { b[bj][0] = *(const f32x4*)((const float*)hin + off + bj * 128); b[bj][1] = *(const f32x4*)((const float*)hin + off + bj * 128 + 4); }
            else unpack8(*(const u32x4*)((const bf16_t*)hin + off + bj * 128), b[bj][0], b[bj][1]); }
    }
    __device__ __forceinline__ void operator()(const f32x4 (&acc)[2][2][4][2], Pre& pre, const Unit& u, int wr, int wc, int fr, int fq) const {
        bf16_t* hb = hb_; float* ss = ss_;
        if (u.pass > 0) { hb = hb_d; ss = ss_d; }
        const int row0 = u.pm * 256 + wr * 64 + fr, col0 = u.pn * 256 + wc * 32 + 8 * fq;
        f32x4 bb[2][2][2];
        ldrow((size_t)ROWOF(0) * DM + col0, bb[0]);
#pragma unroll
        for (int ri = 0; ri < 8; ++ri) { const int r = ROWOF(ri); const size_t off = (size_t)r * DM + col0; float q = 0.f;
            if (ri < 7) ldrow((size_t)ROWOF(ri + 1) * DM + col0, bb[(ri + 1) & 1]);
#pragma unroll
            for (int bj = 0; bj < 2; ++bj) {
                const f32x4 o0 = bb[ri & 1][bj][0] + ACC(ri, bj, 0) * scale, o1 = bb[ri & 1][bj][1] + ACC(ri, bj, 1) * scale;
                *(u32x4*)(hb + off + bj * 128) = pack8(o0, o1);
                q += ((o0[0] * o0[0] + o0[1] * o0[1]) + (o0[2] * o0[2] + o0[3] * o0[3])) + ((o1[0] * o1[0] + o1[1] * o1[1]) + (o1[2] * o1[2] + o1[3] * o1[3])); }
            q += __shfl_xor(q, 16); q += __shfl_xor(q, 32);
            if (fq == 0) atomicAdd(ss + r, q); }
    }
};
struct EpiQKV {
    static constexpr bool PERM = true;
    struct Pre {};
    __device__ __forceinline__ void prefetch(Pre&, const Unit&, int, int, int, int) const {}
    bf16_t* QKV; const float* ss; const float* cosT; const float* sinT;
    __device__ __forceinline__ void operator()(const f32x4 (&acc)[2][2][4][2], Pre& pre, const Unit& u, int wr, int wc, int fr, int fq) const {
        const int sect = u.pn >> 2, hd = u.pn & 3; bf16_t* base = QKV + (size_t)sect * (SLOT / 2);
        const int row0 = u.pm * 256 + wr * 64 + fr, j0 = wc * 32 + 8 * fq; const float ksc = sect == 1 ? 0.0625f : 1.0f;
        float ssv[8];
#pragma unroll
        for (int ri = 0; ri < 8; ++ri) ssv[ri] = ss[ROWOF(ri)];
        f32x4 cs[2][2][2];
#pragma unroll
        for (int n = 0; n < 2; ++n) { cs[0][0][n] = (f32x4){1.f, 1.f, 1.f, 1.f}; cs[0][1][n] = (f32x4){0.f, 0.f, 0.f, 0.f}; cs[1][0][n] = cs[0][0][n]; cs[1][1][n] = cs[0][1][n]; }
        if (sect < 2) { const int pos = ROWOF(0) & (SEQ - 1);
#pragma unroll
            for (int n = 0; n < 2; ++n) { cs[0][0][n] = *(const f32x4*)(cosT + pos * 128 + j0 + 4 * n); cs[0][1][n] = *(const f32x4*)(sinT + pos * 128 + j0 + 4 * n); } }
#pragma unroll
        for (int ri = 0; ri < 8; ++ri) { const int r = ROWOF(ri); const float rs = rs_of(ssv[ri]);
            if (ri < 7 && sect < 2) { const int pos = ROWOF(ri + 1) & (SEQ - 1);
#pragma unroll
                for (int n = 0; n < 2; ++n) { cs[(ri + 1) & 1][0][n] = *(const f32x4*)(cosT + pos * 128 + j0 + 4 * n); cs[(ri + 1) & 1][1][n] = *(const f32x4*)(sinT + pos * 128 + j0 + 4 * n); } }
            f32x4 o1[2], o2[2];
#pragma unroll
            for (int n = 0; n < 2; ++n) { const f32x4 c = cs[ri & 1][0][n], sn = cs[ri & 1][1][n];
                const f32x4 x1 = ACC(ri, 0, n) * rs, x2 = ACC(ri, 1, n) * rs; o1[n] = (x1 * c - x2 * sn) * ksc; o2[n] = (x1 * sn + x2 * c) * ksc; }
            bf16_t* rp = base + (size_t)r * DM + hd * 256 + j0;
            *(u32x4*)(rp) = pack8(o1[0], o1[1]); *(u32x4*)(rp + 128) = pack8(o2[0], o2[1]); }
    }
};
struct EpiGates {
    static constexpr bool PERM = true;
    struct Pre {};
    __device__ __forceinline__ void prefetch(Pre&, const Unit&, int, int, int, int) const {}
    unsigned char* wsb; bf16_t* ohi; const float* ss; const float* gbias;
    __device__ __forceinline__ void operator()(const f32x4 (&acc)[2][2][4][2], Pre& pre, const Unit& u, int wr, int wc, int fr, int fq) const {
        const int sect = u.pn >> 2, ct = (u.pn & 3) * 256; bf16_t* O = sect == 3 ? ohi : (bf16_t*)(wsb + (size_t)((0x726u >> (4 * sect)) & 0xFu) * SLOT);
        const int row0 = u.pm * 256 + wr * 64 + fr, c0 = ct + wc * 32 + 8 * fq;
        float ssv[8];
#pragma unroll
        for (int ri = 0; ri < 8; ++ri) ssv[ri] = ss[ROWOF(ri)];
        f32x4 bv[2][2];
#pragma unroll
        for (int bj = 0; bj < 2; ++bj)
#pragma unroll
            for (int n = 0; n < 2; ++n) bv[bj][n] = sect >= 2 ? *(const f32x4*)(gbias + (sect - 2) * DM + c0 + bj * 128 + 4 * n) : (f32x4){0.f, 0.f, 0.f, 0.f};
#pragma unroll
        for (int ri = 0; ri < 8; ++ri) { const int r = ROWOF(ri); const float rs = rs_of(ssv[ri]);
#pragma unroll
            for (int bj = 0; bj < 2; ++bj) { f32x4 o[2];
#pragma unroll
                for (int n = 0; n < 2; ++n) { const f32x4 v = ACC(ri, bj, n) * rs + bv[bj][n]; o[n] = v; if (sect != 1) { const f32x4 sg = sigm4(v); o[n] = sect == 0 ? v * sg : sg; } }
                *(u32x4*)(O + (size_t)r * DM + c0 + bj * 128) = pack8(o[0], o[1]); } }
    }
};
struct EpiScaleCol {
    static constexpr bool PERM = true;
    struct Pre {};
    __device__ __forceinline__ void prefetch(Pre&, const Unit&, int, int, int, int) const {}
    bf16_t* O; const float* scale;
    __device__ __forceinline__ void operator()(const f32x4 (&acc)[2][2][4][2], Pre& pre, const Unit& u, int wr, int wc, int fr, int fq) const {
        const int row0 = u.pm * 256 + wr * 64 + fr, c0 = u.pn * 256 + wc * 32 + 8 * fq;
        f32x4 sv[2][2];
#pragma unroll
        for (int bj = 0; bj < 2; ++bj)
#pragma unroll
            for (int n = 0; n < 2; ++n) sv[bj][n] = *(const f32x4*)(scale + c0 + bj * 128 + 4 * n);
#pragma unroll
        for (int ri = 0; ri < 8; ++ri) { const int r = ROWOF(ri);
#pragma unroll
            for (int bj = 0; bj < 2; ++bj) *(u32x4*)(O + (size_t)r * DM + c0 + bj * 128) = pack8(ACC(ri, bj, 0) * sv[bj][0], ACC(ri, bj, 1) * sv[bj][1]); }
    }
};
template <bool ADD> struct EpiGateMul {
    static constexpr bool PERM = true;
    struct Pre {};
    __device__ __forceinline__ void prefetch(Pre&, const Unit&, int, int, int, int) const {}
    bf16_t* O; const bf16_t* G; const bf16_t* Min;
    __device__ __forceinline__ void ldrow(size_t off, u32x4 (&g)[2], u32x4 (&a)[2]) const {
#pragma unroll
        for (int bj = 0; bj < 2; ++bj) { g[bj] = *(const u32x4*)(G + off + bj * 128); if (ADD) a[bj] = *(const u32x4*)(Min + off + bj * 128); }
    }
    __device__ __forceinline__ void operator()(const f32x4 (&acc)[2][2][4][2], Pre& pre, const Unit& u, int wr, int wc, int fr, int fq) const {
        const int row0 = u.pm * 256 + wr * 64 + fr, c0 = u.pn * 256 + wc * 32 + 8 * fq;
        u32x4 gb[2][2], ab[2][2];
        ldrow((size_t)ROWOF(0) * DM + c0, gb[0], ab[0]);
#pragma unroll
        for (int ri = 0; ri < 8; ++ri) { const size_t off = (size_t)ROWOF(ri) * DM + c0;
            if (ri < 7) ldrow((size_t)ROWOF(ri + 1) * DM + c0, gb[(ri + 1) & 1], ab[(ri + 1) & 1]);
#pragma unroll
            for (int bj = 0; bj < 2; ++bj) {
                f32x4 g0, g1; unpack8(gb[ri & 1][bj], g0, g1);
                f32x4 o0 = g0 * ACC(ri, bj, 0), o1 = g1 * ACC(ri, bj, 1);
                if (ADD) { f32x4 a0, a1; unpack8(ab[ri & 1][bj], a0, a1); o0 += a0; o1 += a1; }
                *(u32x4*)(O + off + bj * 128) = pack8(o0, o1); } }
    }
};

__device__ __forceinline__ unsigned pk2(float lo, float hi) { return cvt_pk_bf16(lo, hi); }
template <int MODE>
__device__ __forceinline__ void p0_transpose_item(const float* W, int ldw, bf16_t* WT, int ldt, int nblk, const float* gain, LAS float* scr, int item, int lane) {
    const int kb = item / nblk, nb = item % nblk, k0 = 64 * kb, n0 = 32 * nb;
    int sc0 = n0;
    if (MODE == 1) { const int tile = n0 >> 8, r = n0 & 255; sc0 = (r >> 7) * DFF + 128 * tile + (r & 127); }
    f32x4 v[8]; float gv[8];
#pragma unroll
    for (int i = 0; i < 8; ++i) { const int kk = 8 * i + (lane >> 3); v[i] = *(const f32x4*)(W + (size_t)(k0 + kk) * ldw + sc0 + (lane & 7) * 4); gv[i] = gain ? gain[k0 + kk] : 1.0f; }
#pragma unroll
    for (int i = 0; i < 8; ++i) { const int kk = 8 * i + (lane >> 3); LAS float* d = scr + kk * 33 + (lane & 7) * 4;
        d[0] = v[i][0] * gv[i]; d[1] = v[i][1] * gv[i]; d[2] = v[i][2] * gv[i]; d[3] = v[i][3] * gv[i]; }
    asm volatile("s_waitcnt lgkmcnt(0)" ::: "memory");
    const int c = lane & 7;
#pragma unroll
    for (int j = 0; j < 4; ++j) { const int n = (lane >> 3) + 8 * j; const LAS float* s = scr + (8 * c) * 33 + n;
        u32x4 o; o.x = pk2(s[0 * 33], s[1 * 33]); o.y = pk2(s[2 * 33], s[3 * 33]); o.z = pk2(s[4 * 33], s[5 * 33]); o.w = pk2(s[6 * 33], s[7 * 33]);
        *(u32x4*)(WT + (size_t)(n0 + n) * ldt + k0 + 8 * c) = o; }
    asm volatile("s_waitcnt lgkmcnt(0)" ::: "memory");
}

struct Params {
    const float* in[16];
    float* out; unsigned char* ws;
    int ph_lo, ph_hi;
};

__device__ __forceinline__ void p0_prologue(const Params& p, LAS unsigned char* lds) {
    const int tid = threadIdx.x, lane = tid & 63, wave = tid >> 6;
    const int G = gridDim.x, gw = blockIdx.x * 8 + wave, NGW = G * 8;
    unsigned char* ws = p.ws;
    LAS float* scr = (LAS float*)(lds + wave * 16384);
    constexpr int I_1A = 16 * 176, I_1B = 44 * 32, I_IN = 16 * 224, I_PL = 4 * 32, I_SQ = 16 * 32;
    constexpr int NITEMS = 2 * I_1A + 2 * I_1B + I_IN + I_PL + 3 * I_SQ;
    for (int it = gw; it < NITEMS; it += NGW) {
        int r = it;
        if (r < I_1A) { p0_transpose_item<1>(p.in[2], 2 * DFF, (bf16_t*)(ws + WS_W1A), DM, 176, p.in[1], scr, r, lane); continue; } r -= I_1A;
        if (r < I_1A) { p0_transpose_item<1>(p.in[13], 2 * DFF, (bf16_t*)(ws + WS_W2A), DM, 176, p.in[12], scr, r, lane); continue; } r -= I_1A;
        if (r < I_1B) { p0_transpose_item<0>(p.in[3], DM, (bf16_t*)(ws + WS_W1B), DFF, 32, nullptr, scr, r, lane); continue; } r -= I_1B;
        if (r < I_1B) { p0_transpose_item<0>(p.in[14], DM, (bf16_t*)(ws + WS_W2B), DFF, 32, nullptr, scr, r, lane); continue; } r -= I_1B;
        if (r < I_IN) { p0_transpose_item<0>(p.in[5], NIN, (bf16_t*)(ws + WS_WIN), DM, 224, p.in[4], scr, r, lane); continue; } r -= I_IN;
        if (r < I_PL) { const int g = r >> 5; p0_transpose_item<0>(p.in[7] + (size_t)g * 65536, 256, (bf16_t*)(ws + WS_WPL) + (size_t)g * 65536, 256, 8, nullptr, scr, r & 31, lane); continue; } r -= I_PL;
        if (r < I_SQ) { p0_transpose_item<0>(p.in[9], DM, (bf16_t*)(ws + WS_WRU), DM, 32, nullptr, scr, r, lane); continue; } r -= I_SQ;
        if (r < I_SQ) { p0_transpose_item<0>(p.in[10], DM, (bf16_t*)(ws + WS_WPU), DM, 32, nullptr, scr, r, lane); continue; } r -= I_SQ;
        p0_transpose_item<0>(p.in[11], DM, (bf16_t*)(ws + WS_WO), DM, 32, nullptr, scr, r, lane);
    }
    const float* x = p.in[0]; bf16_t* XB = (bf16_t*)(ws + WS_S0); float* ss1 = (float*)(ws + WS_SS1);
    {
        f32x4 vn[4];
        if (gw < MTOK) { const f32x4* xr = (const f32x4*)(x + (size_t)gw * DM) + lane;
#pragma unroll
            for (int j = 0; j < 4; ++j) vn[j] = xr[64 * j]; }
        for (int m = gw; m < MTOK; m += NGW) {
            f32x4 v[4]; float s = 0.f;
#pragma unroll
            for (int j = 0; j < 4; ++j) v[j] = vn[j];
            if (m + NGW < MTOK) { const f32x4* xr = (const f32x4*)(x + (size_t)(m + NGW) * DM) + lane;
#pragma unroll
                for (int j = 0; j < 4; ++j) vn[j] = xr[64 * j]; }
#pragma unroll
            for (int j = 0; j < 4; ++j) s += (v[j][0] * v[j][0] + v[j][1] * v[j][1]) + (v[j][2] * v[j][2] + v[j][3] * v[j][3]);
#pragma unroll
            for (int o = 1; o < 64; o <<= 1) s += __shfl_xor(s, o);
            u32x2* o8 = (u32x2*)(XB + (size_t)m * DM) + lane;
#pragma unroll
            for (int j = 0; j < 4; ++j) { u32x2 w; w.x = pk2(v[j][0], v[j][1]); w.y = pk2(v[j][2], v[j][3]); o8[64 * j] = w; }
            if (lane == 0) ss1[m] = s;
        }
    }
    const int gt = blockIdx.x * 512 + tid, NGT = G * 512;
    float* cosT = (float*)(ws + WS_COS); float* sinT = (float*)(ws + WS_SIN);
    for (int i = gt; i < SEQ * 128; i += NGT) { const int pos = i >> 7, j = i & 127;
        const float inv = exp2f(-(float)j * (13.287712379549449f / 128.0f)); const float ang = (float)pos * inv;
        const double rev = (double)ang * 0.15915494309189533577; const float fr_ = (float)(rev - rint(rev));
        cosT[i] = __builtin_amdgcn_cosf(fr_); sinT[i] = __builtin_amdgcn_sinf(fr_); }
    float* z = (float*)(ws + WS_SS2);
    for (int i = gt; i < MTOK * 3 + MTOK * 4; i += NGT) z[i] = 0.f;
}

template <int O0, int O1, int O2, int O3>
__device__ __forceinline__ void tr4(unsigned addr, s16x4& a, s16x4& b, s16x4& c, s16x4& d) {
    asm volatile("ds_read_b64_tr_b16 %0, %4 offset:%5\n\tds_read_b64_tr_b16 %1, %4 offset:%6\n\tds_read_b64_tr_b16 %2, %4 offset:%7\n\tds_read_b64_tr_b16 %3, %4 offset:%8"
                 : "=&v"(a), "=&v"(b), "=&v"(c), "=&v"(d) : "v"(addr), "i"(O0), "i"(O1), "i"(O2), "i"(O3) : "memory");
}
__device__ __forceinline__ void tr_wait4(s16x4& a, s16x4& b, s16x4& c, s16x4& d) { asm volatile("s_waitcnt lgkmcnt(0)" : "+v"(a), "+v"(b), "+v"(c), "+v"(d) :: "memory"); }
__device__ __forceinline__ bf16x8 cat8(const s16x4 a, const s16x4 b) { bf16x8 r; r[0] = a[0]; r[1] = a[1]; r[2] = a[2]; r[3] = a[3]; r[4] = b[0]; r[5] = b[1]; r[6] = b[2]; r[7] = b[3]; return r; }
__device__ __forceinline__ unsigned short f2bf(float f) { unsigned u = __float_as_uint(f); u += 0x7fffu + ((u >> 16) & 1u); return (unsigned short)(u >> 16); }
__device__ __forceinline__ unsigned pk2s(float lo, float hi) { return pg8::cvt_pk_bf16(lo, hi); }

__device__ __forceinline__ void retention_phase(LAS unsigned char* lds, const bf16_t* Q, const bf16_t* Kb, const bf16_t* V, bf16_t* RET, float* ssr) {
    const int tid = threadIdx.x, wid = __builtin_amdgcn_readfirstlane(tid >> 6), lane = tid & 63, fr = lane & 15, fq = lane >> 4;
    constexpr int QP = 528, VP = 80, PP = 144;
    constexpr int OFF_Q = 0, OFF_K = 33792, OFF_V = 67584, OFF_VD = 72704, OFF_P = 77824, OFF_ST = 87040, ST_BYTES = 16896;
    const unsigned lbase = (unsigned)(size_t)lds;
    const int trq = fr >> 2, trp = fr & 3;
    for (int item = blockIdx.x; item < 256; item += gridDim.x) {
        const int xcd = item & 7, loc = item >> 3, bh = xcd * 4 + (loc >> 3), js = loc & 7, b = bh >> 2, h = bh & 3;
        const float lg = log2f(1.0f - exp2f(-5.0f - (float)h));
        const float cdec = __builtin_amdgcn_exp2f(lg * 64.0f);
        __syncthreads();
        for (int i = tid; i < ST_BYTES / 4; i += 512) ((LAS unsigned*)(lds + OFF_ST))[i] = 0u;
        f32x4 sacc[2][2];
#pragma unroll
        for (int a = 0; a < 2; ++a)
#pragma unroll
            for (int c = 0; c < 2; ++c) sacc[a][c] = (f32x4){0.f, 0.f, 0.f, 0.f};
        const size_t tok0 = (size_t)b * SEQ;
        u32x4 rq[4], rk[4], rv;
#define RET_LOAD(c) do { _Pragma("unroll") for (int _i = 0; _i < 4; ++_i) { const int pc = tid + 512 * _i, row = pc >> 5, ch = pc & 31; const size_t e = (tok0 + 64 * (c) + row) * DM + h * 256 + ch * 8; \
            rq[_i] = *(const u32x4*)(Q + e); rk[_i] = *(const u32x4*)(Kb + e); } \
            if (tid < 256) { const int row = tid >> 2, ch = tid & 3; rv = *(const u32x4*)(V + (tok0 + 64 * (c) + row) * DM + h * 256 + js * 32 + ch * 8); } } while (0)
        RET_LOAD(0);
        for (int c = 0; c < 64; ++c) {
            __syncthreads();
#pragma unroll
            for (int i = 0; i < 4; ++i) { const int pc = tid + 512 * i, row = pc >> 5, ch = pc & 31;
                *(LAS u32x4*)(lds + OFF_Q + row * QP + ch * 16) = rq[i]; *(LAS u32x4*)(lds + OFF_K + row * QP + ch * 16) = rk[i]; }
            if (tid < 256) { const int row = tid >> 2, ch = tid & 3; *(LAS u32x4*)(lds + OFF_V + row * VP + ch * 16) = rv;
                const float kd = __builtin_amdgcn_exp2f(lg * (float)(63 - row)); f32x4 a0, a1; unpack8(rv, a0, a1); a0 *= kd; a1 *= kd;
                u32x4 w; w.x = pk2s(a0[0], a0[1]); w.y = pk2s(a0[2], a0[3]); w.z = pk2s(a1[0], a1[1]); w.w = pk2s(a1[2], a1[3]);
                *(LAS u32x4*)(lds + OFF_VD + row * VP + ch * 16) = w; }
            if (c + 1 < 64) RET_LOAD(c + 1);
            __syncthreads();
            bf16x8 qfc[8];
            {
                const int r = wid >> 1, kb0 = 2 * (wid & 1);
                f32x4 sT[2] = {(f32x4){0.f, 0.f, 0.f, 0.f}, (f32x4){0.f, 0.f, 0.f, 0.f}};
#pragma unroll
                for (int ks = 0; ks < 8; ++ks) {
                    const bf16x8 qf = *(const LAS bf16x8*)(lds + OFF_Q + (16 * r + fr) * QP + (32 * ks + 8 * fq) * 2); qfc[ks] = qf;
#pragma unroll
                    for (int j = 0; j < 2; ++j) { const bf16x8 kf = *(const LAS bf16x8*)(lds + OFF_K + (16 * (kb0 + j) + fr) * QP + (32 * ks + 8 * fq) * 2);
                        sT[j] = __builtin_amdgcn_mfma_f32_16x16x32_bf16(kf, qf, sT[j], 0, 0, 0); }
                }
                const int n = 16 * r + fr;
#pragma unroll
                for (int j = 0; j < 2; ++j) { const int m0 = 16 * (kb0 + j) + 4 * fq; float pv[4];
#pragma unroll
                    for (int i = 0; i < 4; ++i) { const int d = n - (m0 + i); pv[i] = sT[j][i] * __builtin_amdgcn_exp2f(lg * (float)(d < 0 ? -d : d)); }
                    u32x2 w; w.x = pk2s(pv[0], pv[1]); w.y = pk2s(pv[2], pv[3]);
                    *(LAS u32x2*)(lds + OFF_P + n * PP + m0 * 2) = w; }
            }
            {
#pragma unroll
                for (int a = 0; a < 2; ++a)
#pragma unroll
                    for (int cc = 0; cc < 2; ++cc) sacc[a][cc] *= cdec;
                {
                    const int r0 = 8 * fq + trq;
                    s16x4 ta[2][4], tb[2][4];
#pragma unroll
                    for (int a = 0; a < 2; ++a) tr4<0, 4 * QP, 32 * QP, 36 * QP>(lbase + OFF_K + r0 * QP + (16 * (2 * wid + a) + 4 * trp) * 2, ta[a][0], ta[a][1], ta[a][2], ta[a][3]);
#pragma unroll
                    for (int cc = 0; cc < 2; ++cc) tr4<0, 4 * VP, 32 * VP, 36 * VP>(lbase + OFF_VD + r0 * VP + (16 * cc + 4 * trp) * 2, tb[cc][0], tb[cc][1], tb[cc][2], tb[cc][3]);
                    tr_wait4(ta[0][0], ta[0][1], ta[0][2], ta[0][3]); tr_wait4(ta[1][0], ta[1][1], ta[1][2], ta[1][3]);
                    tr_wait4(tb[0][0], tb[0][1], tb[0][2], tb[0][3]); tr_wait4(tb[1][0], tb[1][1], tb[1][2], tb[1][3]);
#pragma unroll
                    for (int ks = 0; ks < 2; ++ks)
#pragma unroll
                        for (int a = 0; a < 2; ++a)
#pragma unroll
                            for (int cc = 0; cc < 2; ++cc) sacc[a][cc] = __builtin_amdgcn_mfma_f32_16x16x32_bf16(cat8(ta[a][2 * ks], ta[a][2 * ks + 1]), cat8(tb[cc][2 * ks], tb[cc][2 * ks + 1]), sacc[a][cc], 0, 0, 0);
                }
                LAS unsigned char* stn = lds + OFF_ST + ((c + 1) & 1) * ST_BYTES;
#pragma unroll
                for (int a = 0; a < 2; ++a)
#pragma unroll
                    for (int cc = 0; cc < 2; ++cc) { u32x2 w; w.x = pk2s(sacc[a][cc][0], sacc[a][cc][1]); w.y = pk2s(sacc[a][cc][2], sacc[a][cc][3]);
                        *(LAS u32x2*)(stn + (16 * cc + fr) * QP + (16 * (2 * wid + a) + 4 * fq) * 2) = w; }
            }
            __syncthreads();
            {
                const int r = wid >> 1, cb = wid & 1;
                f32x4 ain = (f32x4){0.f, 0.f, 0.f, 0.f}, acr = (f32x4){0.f, 0.f, 0.f, 0.f};
                {
                    s16x4 tv[4];
                    tr4<0, 4 * VP, 32 * VP, 36 * VP>(lbase + OFF_V + (8 * fq + trq) * VP + (16 * cb + 4 * trp) * 2, tv[0], tv[1], tv[2], tv[3]);
                    bf16x8 pf[2];
#pragma unroll
                    for (int ks = 0; ks < 2; ++ks) pf[ks] = *(const LAS bf16x8*)(lds + OFF_P + (16 * r + fr) * PP + (32 * ks + 8 * fq) * 2);
                    tr_wait4(tv[0], tv[1], tv[2], tv[3]);
#pragma unroll
                    for (int ks = 0; ks < 2; ++ks) ain = __builtin_amdgcn_mfma_f32_16x16x32_bf16(cat8(tv[2 * ks], tv[2 * ks + 1]), pf[ks], ain, 0, 0, 0);
                }
                const LAS unsigned char* stc = lds + OFF_ST + (c & 1) * ST_BYTES;
#pragma unroll
                for (int ks = 0; ks < 8; ++ks) {
                    const bf16x8 qf = qfc[ks];
                    const bf16x8 sf = *(const LAS bf16x8*)(stc + (16 * cb + fr) * QP + (32 * ks + 8 * fq) * 2);
                    acr = __builtin_amdgcn_mfma_f32_16x16x32_bf16(sf, qf, acr, 0, 0, 0);
                }
                const int n = 16 * r + fr; const float qd = __builtin_amdgcn_exp2f(lg * (float)(n + 1));
                const f32x4 o = ain + acr * qd;
                const size_t t = tok0 + 64 * c + n;
                u32x2 w; w.x = pk2s(o[0], o[1]); w.y = pk2s(o[2], o[3]);
                *(u32x2*)(RET + t * DM + h * 256 + js * 32 + cb * 16 + 4 * fq) = w;
                float q = (o[0] * o[0] + o[1] * o[1]) + (o[2] * o[2] + o[3] * o[3]);
                q += __shfl_xor(q, 16); q += __shfl_xor(q, 32);
                if (fq == 0) atomicAdd(ssr + t * 4 + h, q);
            }
        }
#undef RET_LOAD
    }
}

__device__ __forceinline__ void mix_elementwise(const bf16_t* RET, bf16_t* RN, const bf16_t* GR, const float* ssr, const bf16_t* P, bf16_t* PL) {
    const int gt = blockIdx.x * 512 + threadIdx.x, NGT = gridDim.x * 512;
    constexpr int T = 32;
    for (int item = gt; item < 128 * (MTOK / T); item += NGT) {
        const int ch = item & 127, g = ch >> 5, w = 2 << g; const size_t t0 = (size_t)(item >> 7) * T; const int pos0 = (int)(t0 & (SEQ - 1));
        const size_t base = t0 * DM + ch * 8;
        f32x4 s0 = (f32x4){0.f, 0.f, 0.f, 0.f}, s1 = s0;
        for (int k = 1; k < w; ++k) if (pos0 - k >= 0) { f32x4 b0, b1; unpack8(*(const u32x4*)(P + base - (size_t)k * DM), b0, b1); s0 += b0; s1 += b1; }
        u32x4 pc = *(const u32x4*)(P + base), rc = *(const u32x4*)(RET + base), gc = *(const u32x4*)(GR + base), oc = (u32x4){0u, 0u, 0u, 0u};
        float sq = ssr[t0 * 4 + g];
        if (pos0 + 1 >= w) oc = *(const u32x4*)(P + base - (size_t)(w - 1) * DM);
        for (int j = 0; j < T; ++j) {
            const size_t off = base + (size_t)j * DM; const int pos = pos0 + j;
            const u32x4 pcur = pc, rcur = rc, gcur = gc, ocur = oc; const float sqc = sq;
            if (j + 1 < T) { pc = *(const u32x4*)(P + off + DM); rc = *(const u32x4*)(RET + off + DM); gc = *(const u32x4*)(GR + off + DM); sq = ssr[(t0 + j + 1) * 4 + g];
                if (pos + 2 >= w) oc = *(const u32x4*)(P + off + DM - (size_t)(w - 1) * DM); }
            f32x4 c0, c1; unpack8(pcur, c0, c1); s0 += c0; s1 += c1;
            const int cnt = (pos + 1) < w ? (pos + 1) : w; const float inv = 1.0f / (float)cnt;
            *(u32x4*)(PL + off) = pack8(s0 * inv - c0, s1 * inv - c1);
            if (pos + 1 >= w) { f32x4 o0, o1; unpack8(ocur, o0, o1); s0 -= o0; s1 -= o1; }
            const float rs = __builtin_amdgcn_rsqf(sqc * (1.0f / 256.0f) + EPS);
            f32x4 a0, a1, g0, g1; unpack8(rcur, a0, a1); unpack8(gcur, g0, g1);
            *(u32x4*)(RN + off) = pack8(a0 * rs * g0, a1 * rs * g1);
        }
    }
}

__device__ __forceinline__ void final_norm(const bf16_t* hin, float* out, const float* ss, const float* g) {
    const size_t gt = (size_t)blockIdx.x * 512 + threadIdx.x, NGT = (size_t)gridDim.x * 512, NI = (size_t)MTOK * 128;
    u32x4 hn = (u32x4){0u, 0u, 0u, 0u}; float sn = 1.f;
    if (gt < NI) { hn = *(const u32x4*)(hin + (gt >> 7) * DM + (gt & 127) * 8); sn = ss[gt >> 7]; }
    for (size_t i = gt; i < NI; i += NGT) {
        const size_t t = i >> 7; const int c8 = (int)(i & 127) * 8; const u32x4 hc = hn; const float rs = rs_of(sn);
        const size_t i2 = i + NGT;
        if (i2 < NI) { hn = *(const u32x4*)(hin + (i2 >> 7) * DM + (i2 & 127) * 8); sn = ss[i2 >> 7]; }
        f32x4 v0, v1; unpack8(hc, v0, v1);
        const f32x4 g0 = *(const f32x4*)(g + c8), g1 = *(const f32x4*)(g + c8 + 4);
        *(f32x4*)(out + t * DM + c8) = v0 * rs * g0; *(f32x4*)(out + t * DM + c8 + 4) = v1 * rs * g1;
    }
}

#define XB_TMO      128
#define XB_XCNT(j)  (256  + 64 * (j))
#define XB_XSUB(j)  (1280 + 64 * (j))
#define XB_XGEN(j)  (2304 + 64 * (j))
#define XB_TOP      3328
#define XB_TOPGEN   3392
#define XCD_BAR_WORDS 3456
#define XB_SPIN_CAP (1u << 18)
__device__ __forceinline__ unsigned xb_ld(unsigned* p)              { return __hip_atomic_load(p, __ATOMIC_RELAXED, __HIP_MEMORY_SCOPE_AGENT); }
__device__ __forceinline__ unsigned xb_add(unsigned* p, unsigned v) { return __hip_atomic_fetch_add(p, v, __ATOMIC_RELAXED, __HIP_MEMORY_SCOPE_AGENT); }
__device__ __forceinline__ unsigned xb_xcc_id() { return (unsigned)__builtin_amdgcn_s_getreg((3 << 11) | 20) & 0xFu; }
#define XB_SPIN(cond, bar) do { unsigned _sp = 0; while (cond) { __builtin_amdgcn_s_sleep(1); \
    if ((++_sp & 255u) == 0u) { if (xb_ld(&(bar)[XB_TMO])) break; if (_sp > XB_SPIN_CAP) { atomicAdd(&(bar)[XB_TMO], 1u); break; } } } } while (0)
struct XcdBarrier { unsigned* bar; unsigned x; volatile LAS unsigned* st; };
__device__ __forceinline__ XcdBarrier xcd_barrier_post(unsigned* bar, volatile LAS unsigned* st) {
    XcdBarrier b; b.bar = bar; b.x = xb_xcc_id(); b.st = st;
    if (threadIdx.x == 0) (void)xb_add(&bar[XB_XCNT(b.x)], 1u);
    return b;
}
__device__ __forceinline__ void xcd_barrier_complete(unsigned* bar, unsigned x, unsigned& nloc, unsigned& nx) {
    const unsigned G = gridDim.x * gridDim.y * gridDim.z;
    unsigned sum, cnt, mine, sp = 0u;
    for (;;) {
        sum = 0u; cnt = 0u; mine = 0u;
#pragma unroll
        for (unsigned j = 0; j < 16; ++j) { const unsigned c = xb_ld(&bar[XB_XCNT(j)]); sum += c; cnt += (c > 0u) ? 1u : 0u; mine = (j == x) ? c : mine; }
        if (sum == G) break;
        __builtin_amdgcn_s_sleep(1);
        if ((++sp & 255u) == 0u) { if (xb_ld(&bar[XB_TMO])) break; if (sp > XB_SPIN_CAP) { atomicAdd(&bar[XB_TMO], 1u); break; } }
    }
    nloc = mine > 0u ? mine : 1u; nx = cnt > 0u ? cnt : 1u;
}
__device__ __forceinline__ void xcd_barrier(const XcdBarrier& b) {
    asm volatile("s_waitcnt vmcnt(0)" ::: "memory");
    __syncthreads();
    if (threadIdx.x == 0) {
        unsigned* bar = b.bar;
        __builtin_amdgcn_s_waitcnt(0);
        unsigned nloc = b.st[0], nx = b.st[1];
        if (nloc == 0u) { xcd_barrier_complete(bar, b.x, nloc, nx); b.st[0] = nloc; b.st[1] = nx; }
        const unsigned old = xb_add(&bar[XB_XSUB(b.x)], 1u);
        const unsigned gen = old / nloc;
        if (old + 1u == (gen + 1u) * nloc) {
            __builtin_amdgcn_fence(__ATOMIC_RELEASE, "agent");
            asm volatile("s_waitcnt vmcnt(0)" ::: "memory");
            const unsigned og = xb_add(&bar[XB_TOP], 1u);
            const unsigned tg = og / nx;
            if (og + 1u == (tg + 1u) * nx) xb_add(&bar[XB_TOPGEN], 1u);
            else XB_SPIN(xb_ld(&bar[XB_TOPGEN]) == tg, bar);
            __builtin_amdgcn_fence(__ATOMIC_ACQUIRE, "agent");
            xb_add(&bar[XB_XGEN(b.x)], 1u);
            asm volatile("s_waitcnt vmcnt(0)" ::: "memory");
        } else {
            XB_SPIN(xb_ld(&bar[XB_XGEN(b.x)]) == gen, bar);
            __builtin_amdgcn_fence(__ATOMIC_ACQUIRE, "agent");
            asm volatile("s_waitcnt vmcnt(0)" ::: "memory");
        }
    }
    __syncthreads();
}
constexpr size_t WS_BAR = 62 * MiB;

constexpr int NPHASE = 13;
__global__ void __launch_bounds__(512, 2) fwd_megakernel(Params p) {
    extern __shared__ __attribute__((aligned(16))) unsigned char lds_raw[];
    LAS unsigned char* lds = (LAS unsigned char*)lds_raw;
    unsigned char* ws = p.ws;
    const int G = gridDim.x, c = blockIdx.x;
    bf16_t* S0 = (bf16_t*)(ws + WS_S0); bf16_t* S1 = (bf16_t*)(ws + WS_S1); bf16_t* BIG = (bf16_t*)(ws + WS_BIG);
    bf16_t* B0 = BIG; bf16_t* B1 = BIG + SLOT / 2; bf16_t* B2 = BIG + SLOT; bf16_t* B3 = BIG + 3 * (SLOT / 2);
    float* ss1 = (float*)(ws + WS_SS1); float* ss2 = (float*)(ws + WS_SS2); float* ss3 = (float*)(ws + WS_SS3); float* ss4 = (float*)(ws + WS_SS4); float* ssr = (float*)(ws + WS_SSR);
    const int lo = p.ph_lo, hi = p.ph_hi;
    volatile LAS unsigned* xst = (volatile LAS unsigned*)(lds + pg8::STAGE_BYTES);
    if (threadIdx.x < 4) xst[threadIdx.x] = 0u;
    __syncthreads();
    XcdBarrier xbar = xcd_barrier_post((unsigned*)(ws + WS_BAR), xst);
    bf16_t* OLO = (bf16_t*)p.out; bf16_t* OHI = (bf16_t*)p.out + SLOT / 2;
#ifndef ENMASK
#define ENMASK 0x1fff
#endif
#define IN(k) (((ENMASK >> (k)) & 1) && lo <= (k) && (k) < hi)
    if (p.ph_hi < 0) cg::this_grid().sync();
#define SEAM(k) do { if (IN(k) && IN((k) + 1)) xcd_barrier(xbar); } while (0)
#ifndef REPMASK
#define REPMASK 0
#endif
#define NREP(k) (((REPMASK >> (k)) & 1) ? 2 : 1)
    float* dss = (float*)(ws + 60 * MiB); bf16_t* DUMB = (bf16_t*)(ws + 448 * MiB);
    if (IN(0)) for (int rep = NREP(0); rep > 0; --rep) p0_prologue(p, lds);
    SEAM(0);
    if (IN(1)) {
        pg8::Gemm g{S0, (const bf16_t*)(ws + WS_W1A), DM, DM, DM, 0}; pg8::StaticOrder S; S.init(MTOK, 2 * DFF, G, c, NREP(1));
        EpiSwiglu E{BIG, ss1}; pg8::gemm_phase(lds, g, S, E);
    }
    SEAM(1);
    if (IN(2)) {
        pg8::Gemm g{BIG, (const bf16_t*)(ws + WS_W1B), DFF, DFF, DFF, 0}; pg8::StaticOrder S; S.init(MTOK, DM, G, c, NREP(2));
        EpiResid<true> E{p.in[0], OLO, ss2, 0.5f, DUMB, dss}; pg8::gemm_phase(lds, g, S, E);
    }
    SEAM(2);
    bf16_t* S7 = (bf16_t*)(ws + 448 * MiB);
    if (IN(3)) {
#define RUN_QKV() do { pg8::Gemm g{OLO, (const bf16_t*)(ws + WS_WIN), DM, DM, DM, 0}; pg8::StaticOrder S; S.init(MTOK, 3072, G, c, NREP(3)); \
            EpiQKV E{BIG, ss2, (const float*)(ws + WS_COS), (const float*)(ws + WS_SIN)}; pg8::gemm_phase(lds, g, S, E); } while (0)
#define RUN_GATES() do { pg8::Gemm g{OLO, (const bf16_t*)(ws + WS_WIN) + (size_t)3072 * DM, DM, DM, DM, 0}; pg8::StaticOrder S; S.init(MTOK, 4096, G, c, NREP(5)); \
            EpiGates E{ws, OHI, ss2, p.in[6]}; pg8::gemm_phase(lds, g, S, E); } while (0)
        if ((c >> 3) & 1) { RUN_GATES(); RUN_QKV(); } else { RUN_QKV(); RUN_GATES(); }
#undef RUN_QKV
#undef RUN_GATES
    }
    SEAM(3);
    if (IN(4)) for (int rep = NREP(4); rep > 0; --rep) retention_phase(lds, B0, B1, B2, S0, rep > 1 ? dss : ssr);
    SEAM(4);
    if (IN(6)) for (int rep = NREP(6); rep > 0; --rep) mix_elementwise(S0, B0, B3, ssr, S1, B1);
    if (IN(5) && IN(6) && IN(7)) xcd_barrier(xbar);
    if (IN(7)) {
        {
            pg8::Gemm g{B1, (const bf16_t*)(ws + WS_WPL), DM, 256, 256, 256}; pg8::StaticOrder S; S.init(MTOK, DM, G, c, NREP(7));
            EpiScaleCol E{B2, p.in[8]}; pg8::gemm_phase(lds, g, S, E);
        }
        {
            pg8::Gemm g{B0, (const bf16_t*)(ws + WS_WRU), DM, DM, DM, 0}; pg8::StaticOrder S; S.init(MTOK, DM, G, c, NREP(7));
            EpiGateMul<false> E{S0, S7, nullptr}; pg8::gemm_phase(lds, g, S, E);
        }
    }
    SEAM(7);
    if (IN(8)) {
        pg8::Gemm g{B2, (const bf16_t*)(ws + WS_WPU), DM, DM, DM, 0}; pg8::StaticOrder S; S.init(MTOK, DM, G, c, NREP(8));
        EpiGateMul<true> E{S1, OHI, S0}; pg8::gemm_phase(lds, g, S, E);
    }
    SEAM(8);
    if (IN(9)) {
        pg8::Gemm g{S1, (const bf16_t*)(ws + WS_WO), DM, DM, DM, 0}; pg8::StaticOrder S; S.init(MTOK, DM, G, c, NREP(9));
        EpiResid<false> E{OLO, OHI, ss3, 1.0f, DUMB, dss}; pg8::gemm_phase(lds, g, S, E);
    }
    SEAM(9);
    if (IN(10)) {
        pg8::Gemm g{OHI, (const bf16_t*)(ws + WS_W2A), DM, DM, DM, 0}; pg8::StaticOrder S; S.init(MTOK, 2 * DFF, G, c, NREP(10));
        EpiSwiglu E{BIG, ss3}; pg8::gemm_phase(lds, g, S, E);
    }
    SEAM(10);
    if (IN(11)) {
        pg8::Gemm g{BIG, (const bf16_t*)(ws + WS_W2B), DFF, DFF, DFF, 0}; pg8::StaticOrder S; S.init(MTOK, DM, G, c, NREP(11));
        EpiResid<false> E{OHI, S1, ss4, 0.5f, DUMB, dss}; pg8::gemm_phase(lds, g, S, E);
    }
    SEAM(11);
    if (IN(12)) for (int rep = NREP(12); rep > 0; --rep) final_norm(S1, rep > 1 ? (float*)BIG : p.out, ss4, p.in[15]);
#undef IN
#undef SEAM
}

extern "C" void kernel_launch(void* const* d_in, const int* in_sizes, int n_in, void* d_out, int out_size, void* d_ws, size_t ws_size, hipStream_t stream) {
    constexpr int LDS_BYTES = pg8::STAGE_BYTES + 16;
    static int grid = 0;
    if (grid == 0) {
        if (n_in != 16 || out_size != MTOK * DM || ws_size < WS_END) { fprintf(stderr, "kernel_launch: unexpected shapes (n_in %d out %d ws %zu)\n", n_in, out_size, ws_size); grid = -1; return; }
        int dev = 0, cus = 0, per_cu = 0;
        (void)hipGetDevice(&dev); (void)hipDeviceGetAttribute(&cus, hipDeviceAttributeMultiprocessorCount, dev);
        if (hipFuncSetAttribute((const void*)fwd_megakernel, hipFuncAttributeMaxDynamicSharedMemorySize, LDS_BYTES) != hipSuccess) { fprintf(stderr, "kernel_launch: hipFuncSetAttribute failed\n"); grid = -1; return; }
        if (hipOccupancyMaxActiveBlocksPerMultiprocessor(&per_cu, (const void*)fwd_megakernel, 512, LDS_BYTES) != hipSuccess || per_cu < 1) { fprintf(stderr, "kernel_launch: occupancy query gave %d\n", per_cu); per_cu = 1; }
        (void)hipGetLastError();
        grid = cus;
    }
    if (grid < 0) return;
    if (hipMemsetAsync((char*)d_ws + WS_BAR, 0, XCD_BAR_WORDS * 4, stream) != hipSuccess) { fprintf(stderr, "kernel_launch: memset failed\n"); return; }
    Params p{};
    for (int i = 0; i < 16; ++i) p.in[i] = (const float*)d_in[i];
    p.out = (float*)d_out; p.ws = (unsigned char*)d_ws;
#if N_LAUNCH_MODE == 1
    p.ph_lo = 0; p.ph_hi = NPHASE;
    void* args[] = {&p};
    hipError_t e = hipLaunchCooperativeKernel((const void*)fwd_megakernel, dim3(grid), dim3(512), args, LDS_BYTES, stream);
    if (e != hipSuccess) fprintf(stderr, "cooperative launch failed: %s (grid %d)\n", hipGetErrorString(e), grid);
#else
    for (int ph = 0; ph < NPHASE; ++ph) { p.ph_lo = ph; p.ph_hi = ph + 1; hipLaunchKernelGGL(fwd_megakernel, dim3(grid), dim3(512), LDS_BYTES, stream, p); }
#endif
}
```

```cpp
#include <hip/hip_runtime.h>
#include <hip/hip_cooperative_groups.h>
#include <cstdio>
namespace cg = cooperative_groups;

#ifndef N_LAUNCH_MODE
#define N_LAUNCH_MODE 1
#endif

#define LAS __attribute__((address_space(3)))
typedef unsigned short bf16_t;
typedef short bf16x8 __attribute__((ext_vector_type(8)));
typedef short s16x4 __attribute__((ext_vector_type(4)));
typedef float f32x4 __attribute__((ext_vector_type(4)));
typedef unsigned u32x4 __attribute__((ext_vector_type(4)));
typedef unsigned u32x2 __attribute__((ext_vector_type(2)));

constexpr int MTOK = 32768, DM = 1024, DFF = 2816, SEQ = 4096, NIN = 7168;
constexpr float EPS = 1e-6f;

constexpr size_t MiB = 1024ull * 1024ull;
constexpr size_t WS_W1A = 0;
constexpr size_t WS_W1B = WS_W1A + 5632ull * 1024 * 2;
constexpr size_t WS_WIN = WS_W1B + 1024ull * 2816 * 2;
constexpr size_t WS_WPL = WS_WIN + 7168ull * 1024 * 2;
constexpr size_t WS_WRU = WS_WPL + 1024ull * 256 * 2;
constexpr size_t WS_WPU = WS_WRU + 1024ull * 1024 * 2;
constexpr size_t WS_WO  = WS_WPU + 1024ull * 1024 * 2;
constexpr size_t WS_W2A = WS_WO + 1024ull * 1024 * 2;
constexpr size_t WS_W2B = WS_W2A + 5632ull * 1024 * 2;
constexpr size_t WS_COS = WS_W2B + 1024ull * 2816 * 2;
constexpr size_t WS_SIN = WS_COS + 4096ull * 128 * 4;
constexpr size_t WS_SS1 = WS_SIN + 4096ull * 128 * 4;
constexpr size_t WS_SS2 = WS_SS1 + MTOK * 4ull;
constexpr size_t WS_SS3 = WS_SS2 + MTOK * 4ull;
constexpr size_t WS_SS4 = WS_SS3 + MTOK * 4ull;
constexpr size_t WS_SSR = WS_SS4 + MTOK * 4ull;
constexpr size_t WS_SMALL_END = WS_SSR + MTOK * 16ull;
static_assert(WS_SMALL_END <= 64 * MiB, "weights region");
constexpr size_t WS_S0 = 64 * MiB;
constexpr size_t WS_S1 = 128 * MiB;
constexpr size_t WS_BIG = 192 * MiB;
constexpr size_t WS_END = 512 * MiB;
constexpr size_t SLOT = 64 * MiB;

namespace pg8 {
constexpr int BM = 256, BK = 64, HALF = 128, HTB = HALF * BK * 2, STAGE_BYTES = 8 * HTB, NXCD = 8, WGM = 8;
__host__ __device__ __forceinline__ int lds_byte(int r, int c) { const int st = (r >> 4) * 2 + (c >> 5), rr = r & 15, cc = c & 31, ob = rr * 64 + cc * 2; return st * 1024 + (ob ^ (((ob >> 9) & 1) << 5)); }
__host__ __device__ __forceinline__ void stage_rc(int b, int& R, int& C) { const int st = b / 1024, sb = b % 1024, swz = sb ^ (((sb >> 9) & 1) << 5); R = (st >> 1) * 16 + swz / 64; C = (st & 1) * 32 + (swz % 64) / 2; }
__host__ __device__ __forceinline__ int perm32(int rho) { const int n = rho >> 4, i = rho & 15; return 8 * (i >> 2) + 4 * n + (i & 3); }

struct Unit { int pm, pn, pass; };
struct Gemm { const bf16_t* A; const bf16_t* Bt; int lda, ldb, K; int a_pn_off; };

struct StaticOrder {
    int nM, nN, nwg, G, c, rept;
    __host__ __device__ void init(int M, int N, int G_, int c_, int rept_ = 1) { nM = M / BM; nN = N / BM; nwg = nM * nN; G = G_; c = c_; rept = rept_; }
    __host__ __device__ bool next(int i, Unit& u) const {
        u.pass = 0;
        if (rept > 1) { const int ni = (nwg - c + G - 1) / G; if (ni <= 0 || i >= ni * rept) return false; u.pass = rept - 1 - i / ni; i = i % ni; }
        const long L = (long)i * G + c; if (L >= nwg) return false;
        int wgid = (int)L; { const int q = nwg / NXCD, r = nwg % NXCD, xcd = wgid % NXCD, off = wgid / NXCD; wgid = (xcd < r ? xcd * (q + 1) : r * (q + 1) + (xcd - r) * q) + off; }
        const int nig = WGM * nN, gid = wgid / nig, fm = gid * WGM, gsz = (nM - fm) < WGM ? (nM - fm) : WGM;
        u.pm = fm + ((wgid % nig) % gsz); u.pn = (wgid % nig) / gsz; return true;
    }
};
typedef float f32x2_t __attribute__((ext_vector_type(2)));
typedef __bf16 bf16x2_t __attribute__((ext_vector_type(2)));
__device__ __forceinline__ unsigned cvt_pk_bf16(float lo, float hi) { f32x2_t v = {lo, hi}; bf16x2_t b = __builtin_convertvector(v, bf16x2_t); return __builtin_bit_cast(unsigned, b); }

template <class Epi>
__device__ __forceinline__ void gemm_phase(LAS unsigned char* lds, const Gemm g, const StaticOrder& S, const Epi& E) {
    const int tid = threadIdx.x, wid = __builtin_amdgcn_readfirstlane(tid >> 6), lane = tid & 63, wr = wid >> 2, wc = wid & 3, fr = lane & 15, fq = lane >> 4;
    const int K = g.K, nt = K / BK;
    unsigned voffA[2], voffB[2];
#pragma unroll
    for (int i = 0; i < 2; ++i) { int R, C; stage_rc(tid * 16 + i * 8192, R, C); const int Rb = Epi::PERM ? ((R & ~31) + perm32(R & 31)) : R;
        voffA[i] = (unsigned)(R * g.lda + C) * 2u; voffB[i] = (unsigned)(Rb * g.ldb + C) * 2u; }
    const size_t kstep = (size_t)(BK * 2);
    const size_t hstepA = (size_t)HALF * g.lda * 2, hstepB = (size_t)HALF * g.ldb * 2;
    const size_t tstepA = 2 * hstepA, tstepB = 2 * hstepB;
    const unsigned ldsw = (unsigned)wid * 1024u;
    const int aoff = lds_byte(wr * 64 + fr, fq * 8), boff = lds_byte(wc * 32 + fr, fq * 8);
#define PG8_SA(b, h) (((b) * 2 + (h)) * HTB)
#define PG8_SB(b, h) ((4 + (b) * 2 + (h)) * HTB)
#define PG8_STAGE(bufoff, gbase, voff) do { _Pragma("unroll") for (int _i = 0; _i < 2; ++_i) \
        __builtin_amdgcn_global_load_lds((const unsigned*)((const char*)(gbase) + (voff)[_i]), (LAS unsigned*)(lds + (bufoff) + ldsw + _i * 8192), 16, 0, 0); } while (0)
#define PG8_LDA(dst, b, h) do { _Pragma("unroll") for (int m = 0; m < 4; ++m) _Pragma("unroll") for (int k = 0; k < 2; ++k) dst[m][k] = *(const LAS bf16x8*)(lds + PG8_SA(b, h) + aoff + m * 2048 + k * 1024); } while (0)
#define PG8_LDB(dst, b, h) do { _Pragma("unroll") for (int n = 0; n < 2; ++n) _Pragma("unroll") for (int k = 0; k < 2; ++k) dst[n][k] = *(const LAS bf16x8*)(lds + PG8_SB(b, h) + boff + n * 2048 + k * 1024); } while (0)
#define PG8_MMA(ai, bj, At, Bt) do { __builtin_amdgcn_s_setprio(1); _Pragma("unroll") for (int m = 0; m < 4; ++m) _Pragma("unroll") for (int n = 0; n < 2; ++n) _Pragma("unroll") for (int k = 0; k < 2; ++k) \
        acc[ai][bj][m][n] = __builtin_amdgcn_mfma_f32_16x16x32_bf16(Bt[n][k], At[m][k], acc[ai][bj][m][n], 0, 0, 0); __builtin_amdgcn_s_setprio(0); } while (0)
#define PG8_WAIT_V(n) asm volatile("s_waitcnt vmcnt(" #n ")" ::: "memory")
#define PG8_WAIT_L(n) asm volatile("s_waitcnt lgkmcnt(" #n ")" ::: "memory")
#define PG8_BAR __builtin_amdgcn_s_barrier()
#define PG8_SCHED __builtin_amdgcn_sched_barrier(0)
    Unit cur, nxt; int ui = 0;
    if (!S.next(0, cur)) return;
    typename Epi::Pre pre;
    f32x4 acc[2][2][4][2];
#pragma unroll
    for (int a = 0; a < 2; ++a)
#pragma unroll
        for (int b = 0; b < 2; ++b)
#pragma unroll
            for (int m = 0; m < 4; ++m)
#pragma unroll
                for (int n = 0; n < 2; ++n) acc[a][b][m][n] = (f32x4){0.f, 0.f, 0.f, 0.f};
    bf16x8 At[4][2], B0[2][2], B1[2][2];
    const char* cA = (const char*)g.A + (size_t)cur.pm * tstepA + (size_t)cur.pn * g.a_pn_off * 2; const char* cB = (const char*)g.Bt + (size_t)cur.pn * tstepB;
    PG8_STAGE(PG8_SB(0, 0), cB, voffB); PG8_STAGE(PG8_SB(0, 1), cB + hstepB, voffB); PG8_STAGE(PG8_SA(0, 0), cA, voffA); PG8_STAGE(PG8_SA(0, 1), cA + hstepA, voffA);
    if (wr == 1) PG8_BAR;
    PG8_WAIT_V(2); PG8_BAR;
    PG8_STAGE(PG8_SB(1, 0), cB + kstep, voffB); PG8_STAGE(PG8_SA(1, 0), cA + kstep, voffA); PG8_STAGE(PG8_SB(1, 1), cB + hstepB + kstep, voffB);
    PG8_WAIT_V(6); PG8_BAR;
    for (;;) {
        const bool has_next = S.next(ui + 1, nxt);
        const char* nA = has_next ? (const char*)g.A + (size_t)nxt.pm * tstepA + (size_t)nxt.pn * g.a_pn_off * 2 : cA; const char* nB = has_next ? (const char*)g.Bt + (size_t)nxt.pn * tstepB : cB;
#pragma unroll 1
        for (int t = 0; t < nt; t += 2) {
            const bool last = (t == nt - 2);
            const char* a1 = cA + (size_t)(t + 1) * kstep;
            const char* a2 = last ? nA : cA + (size_t)(t + 2) * kstep; const char* b2 = last ? nB : cB + (size_t)(t + 2) * kstep;
            const char* a3 = a2 + kstep; const char* b3 = b2 + kstep;
            if (last) E.prefetch(pre, cur, wr, wc, fr, fq);
            PG8_LDB(B0, 0, 0); PG8_LDB(B1, 0, 1); PG8_SCHED; PG8_LDA(At, 0, 0); PG8_STAGE(PG8_SA(1, 1), a1 + hstepA, voffA);
            PG8_WAIT_V(8); PG8_WAIT_L(0); PG8_BAR; PG8_MMA(0, 0, At, B0); PG8_MMA(0, 1, At, B1); PG8_BAR; PG8_SCHED;
            PG8_LDA(At, 0, 1); PG8_STAGE(PG8_SB(0, 0), b2, voffB); PG8_STAGE(PG8_SB(0, 1), b2 + hstepB, voffB); PG8_STAGE(PG8_SA(0, 0), a2, voffA);
            PG8_WAIT_V(8); PG8_WAIT_L(0); PG8_BAR; PG8_MMA(1, 0, At, B0); PG8_MMA(1, 1, At, B1); PG8_BAR; PG8_SCHED;
            PG8_LDB(B0, 1, 0); PG8_LDB(B1, 1, 1); PG8_SCHED; PG8_LDA(At, 1, 0); PG8_STAGE(PG8_SA(0, 1), a2 + hstepA, voffA);
            PG8_WAIT_V(8); PG8_WAIT_L(0); PG8_BAR; PG8_MMA(0, 0, At, B0); PG8_MMA(0, 1, At, B1); PG8_BAR; PG8_SCHED;
            PG8_LDA(At, 1, 1); PG8_STAGE(PG8_SB(1, 0), b3, voffB); PG8_STAGE(PG8_SB(1, 1), b3 + hstepB, voffB); PG8_STAGE(PG8_SA(1, 0), a3, voffA);
            PG8_WAIT_V(8); PG8_WAIT_L(0); PG8_BAR; PG8_MMA(1, 0, At, B0); PG8_MMA(1, 1, At, B1); PG8_BAR; PG8_SCHED;
        }
        if (wr == 0) PG8_BAR;
        E(acc, pre, cur, wr, wc, fr, fq);
        if (wr == 1) PG8_BAR;
        if (!has_next) break;
#pragma unroll
        for (int a = 0; a < 2; ++a)
#pragma unroll
            for (int b = 0; b < 2; ++b)
#pragma unroll
                for (int m = 0; m < 4; ++m)
#pragma unroll
                    for (int n = 0; n < 2; ++n) acc[a][b][m][n] = (f32x4){0.f, 0.f, 0.f, 0.f};
        cur = nxt; cA = nA; cB = nB; ++ui;
    }
    PG8_WAIT_V(0);
    if (wr == 0) PG8_BAR;
    PG8_BAR;
#undef PG8_SA
#undef PG8_SB
#undef PG8_STAGE
#undef PG8_LDA
#undef PG8_LDB
#undef PG8_MMA
#undef PG8_WAIT_V
#undef PG8_WAIT_L
#undef PG8_BAR
#undef PG8_SCHED
}
}
using pg8::cvt_pk_bf16;
using pg8::Unit;

__device__ __forceinline__ float sigm_f(float g) { return __builtin_amdgcn_rcpf(1.0f + __builtin_amdgcn_exp2f(g * -1.4426950408889634f)); }
__device__ __forceinline__ float silu_f(float g) { return g * sigm_f(g); }
__device__ __forceinline__ f32x4 sigm4(const f32x4 g) { const f32x4 a = g * -1.4426950408889634f; f32x4 e; e[0] = __builtin_amdgcn_exp2f(a[0]); e[1] = __builtin_amdgcn_exp2f(a[1]); e[2] = __builtin_amdgcn_exp2f(a[2]); e[3] = __builtin_amdgcn_exp2f(a[3]);
    const f32x4 d = e + 1.0f; f32x4 r; r[0] = __builtin_amdgcn_rcpf(d[0]); r[1] = __builtin_amdgcn_rcpf(d[1]); r[2] = __builtin_amdgcn_rcpf(d[2]); r[3] = __builtin_amdgcn_rcpf(d[3]); return r; }
__device__ __forceinline__ float rs_of(float ss) { return __builtin_amdgcn_rsqf(ss * (1.0f / 1024.0f) + EPS); }
__device__ __forceinline__ float bf2f(unsigned short b) { return __uint_as_float(((unsigned)b) << 16); }
__device__ __forceinline__ u32x4 pack8(const f32x4 a, const f32x4 b) { u32x4 w; w.x = cvt_pk_bf16(a[0], a[1]); w.y = cvt_pk_bf16(a[2], a[3]); w.z = cvt_pk_bf16(b[0], b[1]); w.w = cvt_pk_bf16(b[2], b[3]); return w; }
__device__ __forceinline__ void unpack8(const u32x4 w, f32x4& a, f32x4& b) {
    a[0] = __uint_as_float(w.x << 16); a[1] = __uint_as_float(w.x & 0xffff0000u); a[2] = __uint_as_float(w.y << 16); a[3] = __uint_as_float(w.y & 0xffff0000u);
    b[0] = __uint_as_float(w.z << 16); b[1] = __uint_as_float(w.z & 0xffff0000u); b[2] = __uint_as_float(w.w << 16); b[3] = __uint_as_float(w.w & 0xffff0000u); }

#define ROWOF(ri) (row0 + ((ri) >> 2) * 128 + ((ri) & 3) * 16)
#define ACC(ri, bj, n) acc[(ri) >> 2][bj][(ri) & 3][n]
struct EpiSwiglu {
    static constexpr bool PERM = true;
    struct Pre {};
    __device__ __forceinline__ void prefetch(Pre&, const Unit&, int, int, int, int) const {}
    bf16_t* O; const float* ss;
    __device__ __forceinline__ void operator()(const f32x4 (&acc)[2][2][4][2], Pre& pre, const Unit& u, int wr, int wc, int fr, int fq) const {
        const int row0 = u.pm * 256 + wr * 64 + fr, col0 = u.pn * 128 + wc * 32 + 8 * fq;
        float ssv[8];
#pragma unroll
        for (int ri = 0; ri < 8; ++ri) ssv[ri] = ss[ROWOF(ri)];
#pragma unroll
        for (int ri = 0; ri < 8; ++ri) { const int r = ROWOF(ri); const float rs = rs_of(ssv[ri]);
            f32x4 o[2];
#pragma unroll
            for (int n = 0; n < 2; ++n) { const f32x4 gt = ACC(ri, 0, n) * rs, up = ACC(ri, 1, n) * rs; o[n] = (gt * up) * sigm4(gt); }
            *(u32x4*)(O + (size_t)r * DFF + col0) = pack8(o[0], o[1]); }
    }
};
template <bool IN_F32> struct EpiResid {
    static constexpr bool PERM = true;
    struct Pre {};
    __device__ __forceinline__ void prefetch(Pre&, const Unit&, int, int, int, int) const {}
    const void* hin; bf16_t* hb_; float* ss_; float scale; bf16_t* hb_d; float* ss_d;
    __device__ __forceinline__ void ldrow(size_t off, f32x4 (&b)[2][2]) const {
#pragma unroll
        for (int bj = 0; bj < 2; ++bj) {
            if (IN_F32) { b[bj][0] = *(const f32x4*)((const float*)hin + off + bj * 128); b[bj][1] = *(const f32x4*)((const float*)hin + off + bj * 128 + 4); }
            else unpack8(*(const u32x4*)((const bf16_t*)hin + off + bj * 128), b[bj][0], b[bj][1]); }
    }
    __device__ __forceinline__ void operator()(const f32x4 (&acc)[2][2][4][2], Pre& pre, const Unit& u, int wr, int wc, int fr, int fq) const {
        bf16_t* hb = hb_; float* ss = ss_;
        if (u.pass > 0) { hb = hb_d; ss = ss_d; }
        const int row0 = u.pm * 256 + wr * 64 + fr, col0 = u.pn * 256 + wc * 32 + 8 * fq;
        f32x4 bb[2][2][2];
        ldrow((size_t)ROWOF(0) * DM + col0, bb[0]);
#pragma unroll
        for (int ri = 0; ri < 8; ++ri) { const int r = ROWOF(ri); const size_t off = (size_t)r * DM + col0; float q = 0.f;
            if (ri < 7) ldrow((size_t)ROWOF(ri + 1) * DM + col0, bb[(ri + 1) & 1]);
#pragma unroll
            for (int bj = 0; bj < 2; ++bj) {
                const f32x4 o0 = bb[ri & 1][bj][0] + ACC(ri, bj, 0) * scale, o1 = bb[ri & 1][bj][1] + ACC(ri, bj, 1) * scale;
                *(u32x4*)(hb + off + bj * 128) = pack8(o0, o1);
                q += ((o0[0] * o0[0] + o0[1] * o0[1]) + (o0[2] * o0[2] + o0[3] * o0[3])) + ((o1[0] * o1[0] + o1[1] * o1[1]) + (o1[2] * o1[2] + o1[3] * o1[3])); }
            q += __shfl_xor(q, 16); q += __shfl_xor(q, 32);
            if (fq == 0) atomicAdd(ss + r, q); }
    }
};
struct EpiQKV {
    static constexpr bool PERM = true;
    struct Pre {};
    __device__ __forceinline__ void prefetch(Pre&, const Unit&, int, int, int, int) const {}
    bf16_t* QKV; const float* ss; const float* cosT; const float* sinT;
    __device__ __forceinline__ void operator()(const f32x4 (&acc)[2][2][4][2], Pre& pre, const Unit& u, int wr, int wc, int fr, int fq) const {
        const int sect = u.pn >> 2, hd = u.pn & 3; bf16_t* base = QKV + (size_t)sect * (SLOT / 2);
        const int row0 = u.pm * 256 + wr * 64 + fr, j0 = wc * 32 + 8 * fq; const float ksc = sect == 1 ? 0.0625f : 1.0f;
        float ssv[8];
#pragma unroll
        for (int ri = 0; ri < 8; ++ri) ssv[ri] = ss[ROWOF(ri)];
        f32x4 cs[2][2][2];
#pragma unroll
        for (int n = 0; n < 2; ++n) { cs[0][0][n] = (f32x4){1.f, 1.f, 1.f, 1.f}; cs[0][1][n] = (f32x4){0.f, 0.f, 0.f, 0.f}; cs[1][0][n] = cs[0][0][n]; cs[1][1][n] = cs[0][1][n]; }
        if (sect < 2) { const int pos = ROWOF(0) & (SEQ - 1);
#pragma unroll
            for (int n = 0; n < 2; ++n) { cs[0][0][n] = *(const f32x4*)(cosT + pos * 128 + j0 + 4 * n); cs[0][1][n] = *(const f32x4*)(sinT + pos * 128 + j0 + 4 * n); } }
#pragma unroll
        for (int ri = 0; ri < 8; ++ri) { const int r = ROWOF(ri); const float rs = rs_of(ssv[ri]);
            if (ri < 7 && sect < 2) { const int pos = ROWOF(ri + 1) & (SEQ - 1);
#pragma unroll
                for (int n = 0; n < 2; ++n) { cs[(ri + 1) & 1][0][n] = *(const f32x4*)(cosT + pos * 128 + j0 + 4 * n); cs[(ri + 1) & 1][1][n] = *(const f32x4*)(sinT + pos * 128 + j0 + 4 * n); } }
            f32x4 o1[2], o2[2];
#pragma unroll
            for (int n = 0; n < 2; ++n) { const f32x4 c = cs[ri & 1][0][n], sn = cs[ri & 1][1][n];
                const f32x4 x1 = ACC(ri, 0, n) * rs, x2 = ACC(ri, 1, n) * rs; o1[n] = (x1 * c - x2 * sn) * ksc; o2[n] = (x1 * sn + x2 * c) * ksc; }
            bf16_t* rp = base + (size_t)r * DM + hd * 256 + j0;
            *(u32x4*)(rp) = pack8(o1[0], o1[1]); *(u32x4*)(rp + 128) = pack8(o2[0], o2[1]); }
    }
};
struct EpiGates {
    static constexpr bool PERM = true;
    struct Pre {};
    __device__ __forceinline__ void prefetch(Pre&, const Unit&, int, int, int, int) const {}
    unsigned char* wsb; bf16_t* ohi; const float* ss; const float* gbias;
    __device__ __forceinline__ void operator()(const f32x4 (&acc)[2][2][4][2], Pre& pre, const Unit& u, int wr, int wc, int fr, int fq) const {
        const int sect = u.pn >> 2, ct = (u.pn & 3) * 256; bf16_t* O = sect == 3 ? ohi : (bf16_t*)(wsb + (size_t)((0x726u >> (4 * sect)) & 0xFu) * SLOT);
        const int row0 = u.pm * 256 + wr * 64 + fr, c0 = ct + wc * 32 + 8 * fq;
        float ssv[8];
#pragma unroll
        for (int ri = 0; ri < 8; ++ri) ssv[ri] = ss[ROWOF(ri)];
        f32x4 bv[2][2];
#pragma unroll
        for (int bj = 0; bj < 2; ++bj)
#pragma unroll
            for (int n = 0; n < 2; ++n) bv[bj][n] = sect >= 2 ? *(const f32x4*)(gbias + (sect - 2) * DM + c0 + bj * 128 + 4 * n) : (f32x4){0.f, 0.f, 0.f, 0.f};
#pragma unroll
        for (int ri = 0; ri < 8; ++ri) { const int r = ROWOF(ri); const float rs = rs_of(ssv[ri]);
#pragma unroll
            for (int bj = 0; bj < 2; ++bj) { f32x4 o[2];
#pragma unroll
                for (int n = 0; n < 2; ++n) { const f32x4 v = ACC(ri, bj, n) * rs + bv[bj][n]; o[n] = v; if (sect != 1) { const f32x4 sg = sigm4(v); o[n] = sect == 0 ? v * sg : sg; } }
                *(u32x4*)(O + (size_t)r * DM + c0 + bj * 128) = pack8(o[0], o[1]); } }
    }
};
struct EpiScaleCol {
    static constexpr bool PERM = true;
    struct Pre {};
    __device__ __forceinline__ void prefetch(Pre&, const Unit&, int, int, int, int) const {}
    bf16_t* O; const float* scale;
    __device__ __forceinline__ void operator()(const f32x4 (&acc)[2][2][4][2], Pre& pre, const Unit& u, int wr, int wc, int fr, int fq) const {
        const int row0 = u.pm * 256 + wr * 64 + fr, c0 = u.pn * 256 + wc * 32 + 8 * fq;
        f32x4 sv[2][2];
#pragma unroll
        for (int bj = 0; bj < 2; ++bj)
#pragma unroll
            for (int n = 0; n < 2; ++n) sv[bj][n] = *(const f32x4*)(scale + c0 + bj * 128 + 4 * n);
#pragma unroll
        for (int ri = 0; ri < 8; ++ri) { const int r = ROWOF(ri);
#pragma unroll
            for (int bj = 0; bj < 2; ++bj) *(u32x4*)(O + (size_t)r * DM + c0 + bj * 128) = pack8(ACC(ri, bj, 0) * sv[bj][0], ACC(ri, bj, 1) * sv[bj][1]); }
    }
};
template <bool ADD> struct EpiGateMul {
    static constexpr bool PERM = true;
    struct Pre {};
    __device__ __forceinline__ void prefetch(Pre&, const Unit&, int, int, int, int) const {}
    bf16_t* O; const bf16_t* G; const bf16_t* Min;
    __device__ __forceinline__ void ldrow(size_t off, u32x4 (&g)[2], u32x4 (&a)[2]) const {
#pragma unroll
        for (int bj = 0; bj < 2; ++bj) { g[bj] = *(const u32x4*)(G + off + bj * 128); if (ADD) a[bj] = *(const u32x4*)(Min + off + bj * 128); }
    }
    __device__ __forceinline__ void operator()(const f32x4 (&acc)[2][2][4][2], Pre& pre, const Unit& u, int wr, int wc, int fr, int fq) const {
        const int row0 = u.pm * 256 + wr * 64 + fr, c0 = u.pn * 256 + wc * 32 + 8 * fq;
        u32x4 gb[2][2], ab[2][2];
        ldrow((size_t)ROWOF(0) * DM + c0, gb[0], ab[0]);
#pragma unroll
        for (int ri = 0; ri < 8; ++ri) { const size_t off = (size_t)ROWOF(ri) * DM + c0;
            if (ri < 7) ldrow((size_t)ROWOF(ri + 1) * DM + c0, gb[(ri + 1) & 1], ab[(ri + 1) & 1]);
#pragma unroll
            for (int bj = 0; bj < 2; ++bj) {
                f32x4 g0, g1; unpack8(gb[ri & 1][bj], g0, g1);
                f32x4 o0 = g0 * ACC(ri, bj, 0), o1 = g1 * ACC(ri, bj, 1);
                if (ADD) { f32x4 a0, a1; unpack8(ab[ri & 1][bj], a0, a1); o0 += a0; o1 += a1; }
                *(u32x4*)(O + off + bj * 128) = pack8(o0, o1); } }
    }
};

__device__ __forceinline__ unsigned pk2(float lo, float hi) { return cvt_pk_bf16(lo, hi); }
template <int MODE>
__device__ __forceinline__ void p0_transpose_item(const float* W, int ldw, bf16_t* WT, int ldt, int nblk, const float* gain, LAS float* scr, int item, int lane) {
    const int kb = item / nblk, nb = item % nblk, k0 = 64 * kb, n0 = 32 * nb;
    int sc0 = n0;
    if (MODE == 1) { const int tile = n0 >> 8, r = n0 & 255; sc0 = (r >> 7) * DFF + 128 * tile + (r & 127); }
    f32x4 v[8]; float gv[8];
#pragma unroll
    for (int i = 0; i < 8; ++i) { const int kk = 8 * i + (lane >> 3); v[i] = *(const f32x4*)(W + (size_t)(k0 + kk) * ldw + sc0 + (lane & 7) * 4); gv[i] = gain ? gain[k0 + kk] : 1.0f; }
#pragma unroll
    for (int i = 0; i < 8; ++i) { const int kk = 8 * i + (lane >> 3); LAS float* d = scr + kk * 33 + (lane & 7) * 4;
        d[0] = v[i][0] * gv[i]; d[1] = v[i][1] * gv[i]; d[2] = v[i][2] * gv[i]; d[3] = v[i][3] * gv[i]; }
    asm volatile("s_waitcnt lgkmcnt(0)" ::: "memory");
    const int c = lane & 7;
#pragma unroll
    for (int j = 0; j < 4; ++j) { const int n = (lane >> 3) + 8 * j; const LAS float* s = scr + (8 * c) * 33 + n;
        u32x4 o; o.x = pk2(s[0 * 33], s[1 * 33]); o.y = pk2(s[2 * 33], s[3 * 33]); o.z = pk2(s[4 * 33], s[5 * 33]); o.w = pk2(s[6 * 33], s[7 * 33]);
        *(u32x4*)(WT + (size_t)(n0 + n) * ldt + k0 + 8 * c) = o; }
    asm volatile("s_waitcnt lgkmcnt(0)" ::: "memory");
}

struct Params {
    const float* in[16];
    float* out; unsigned char* ws;
    int ph_lo, ph_hi;
};

__device__ __forceinline__ void p0_prologue(const Params& p, LAS unsigned char* lds) {
    const int tid = threadIdx.x, lane = tid & 63, wave = tid >> 6;
    const int G = gridDim.x, gw = blockIdx.x * 8 + wave, NGW = G * 8;
    unsigned char* ws = p.ws;
    LAS float* scr = (LAS float*)(lds + wave * 16384);
    constexpr int I_1A = 16 * 176, I_1B = 44 * 32, I_IN = 16 * 224, I_PL = 4 * 32, I_SQ = 16 * 32;
    constexpr int NITEMS = 2 * I_1A + 2 * I_1B + I_IN + I_PL + 3 * I_SQ;
    for (int it = gw; it < NITEMS; it += NGW) {
        int r = it;
        if (r < I_1A) { p0_transpose_item<1>(p.in[2], 2 * DFF, (bf16_t*)(ws + WS_W1A), DM, 176, p.in[1], scr, r, lane); continue; } r -= I_1A;
        if (r < I_1A) { p0_transpose_item<1>(p.in[13], 2 * DFF, (bf16_t*)(ws + WS_W2A), DM, 176, p.in[12], scr, r, lane); continue; } r -= I_1A;
        if (r < I_1B) { p0_transpose_item<0>(p.in[3], DM, (bf16_t*)(ws + WS_W1B), DFF, 32, nullptr, scr, r, lane); continue; } r -= I_1B;
        if (r < I_1B) { p0_transpose_item<0>(p.in[14], DM, (bf16_t*)(ws + WS_W2B), DFF, 32, nullptr, scr, r, lane); continue; } r -= I_1B;
        if (r < I_IN) { p0_transpose_item<0>(p.in[5], NIN, (bf16_t*)(ws + WS_WIN), DM, 224, p.in[4], scr, r, lane); continue; } r -= I_IN;
        if (r < I_PL) { const int g = r >> 5; p0_transpose_item<0>(p.in[7] + (size_t)g * 65536, 256, (bf16_t*)(ws + WS_WPL) + (size_t)g * 65536, 256, 8, nullptr, scr, r & 31, lane); continue; } r -= I_PL;
        if (r < I_SQ) { p0_transpose_item<0>(p.in[9], DM, (bf16_t*)(ws + WS_WRU), DM, 32, nullptr, scr, r, lane); continue; } r -= I_SQ;
        if (r < I_SQ) { p0_transpose_item<0>(p.in[10], DM, (bf16_t*)(ws + WS_WPU), DM, 32, nullptr, scr, r, lane); continue; } r -= I_SQ;
        p0_transpose_item<0>(p.in[11], DM, (bf16_t*)(ws + WS_WO), DM, 32, nullptr, scr, r, lane);
    }
    const float* x = p.in[0]; bf16_t* XB = (bf16_t*)(ws + WS_S0); float* ss1 = (float*)(ws + WS_SS1);
    {
        f32x4 vn[4];
        if (gw < MTOK) { const f32x4* xr = (const f32x4*)(x + (size_t)gw * DM) + lane;
#pragma unroll
            for (int j = 0; j < 4; ++j) vn[j] = xr[64 * j]; }
        for (int m = gw; m < MTOK; m += NGW) {
            f32x4 v[4]; float s = 0.f;
#pragma unroll
            for (int j = 0; j < 4; ++j) v[j] = vn[j];
            if (m + NGW < MTOK) { const f32x4* xr = (const f32x4*)(x + (size_t)(m + NGW) * DM) + lane;
#pragma unroll
                for (int j = 0; j < 4; ++j) vn[j] = xr[64 * j]; }
#pragma unroll
            for (int j = 0; j < 4; ++j) s += (v[j][0] * v[j][0] + v[j][1] * v[j][1]) + (v[j][2] * v[j][2] + v[j][3] * v[j][3]);
#pragma unroll
            for (int o = 1; o < 64; o <<= 1) s += __shfl_xor(s, o);
            u32x2* o8 = (u32x2*)(XB + (size_t)m * DM) + lane;
#pragma unroll
            for (int j = 0; j < 4; ++j) { u32x2 w; w.x = pk2(v[j][0], v[j][1]); w.y = pk2(v[j][2], v[j][3]); o8[64 * j] = w; }
            if (lane == 0) ss1[m] = s;
        }
    }
    const int gt = blockIdx.x * 512 + tid, NGT = G * 512;
    float* cosT = (float*)(ws + WS_COS); float* sinT = (float*)(ws + WS_SIN);
    for (int i = gt; i < SEQ * 128; i += NGT) { const int pos = i >> 7, j = i & 127;
        const float inv = exp2f(-(float)j * (13.287712379549449f / 128.0f)); const float ang = (float)pos * inv;
        const double rev = (double)ang * 0.15915494309189533577; const float fr_ = (float)(rev - rint(rev));
        cosT[i] = __builtin_amdgcn_cosf(fr_); sinT[i] = __builtin_amdgcn_sinf(fr_); }
    float* z = (float*)(ws + WS_SS2);
    for (int i = gt; i < MTOK * 3 + MTOK * 4; i += NGT) z[i] = 0.f;
}

template <int O0, int O1, int O2, int O3>
__device__ __forceinline__ void tr4(unsigned addr, s16x4& a, s16x4& b, s16x4& c, s16x4& d) {
    asm volatile("ds_read_b64_tr_b16 %0, %4 offset:%5\n\tds_read_b64_tr_b16 %1, %4 offset:%6\n\tds_read_b64_tr_b16 %2, %4 offset:%7\n\tds_read_b64_tr_b16 %3, %4 offset:%8"
                 : "=&v"(a), "=&v"(b), "=&v"(c), "=&v"(d) : "v"(addr), "i"(O0), "i"(O1), "i"(O2), "i"(O3) : "memory");
}
__device__ __forceinline__ void tr_wait4(s16x4& a, s16x4& b, s16x4& c, s16x4& d) { asm volatile("s_waitcnt lgkmcnt(0)" : "+v"(a), "+v"(b), "+v"(c), "+v"(d) :: "memory"); }
__device__ __forceinline__ bf16x8 cat8(const s16x4 a, const s16x4 b) { bf16x8 r; r[0] = a[0]; r[1] = a[1]; r[2] = a[2]; r[3] = a[3]; r[4] = b[0]; r[5] = b[1]; r[6] = b[2]; r[7] = b[3]; return r; }
__device__ __forceinline__ unsigned short f2bf(float f) { unsigned u = __float_as_uint(f); u += 0x7fffu + ((u >> 16) & 1u); return (unsigned short)(u >> 16); }
__device__ __forceinline__ unsigned pk2s(float lo, float hi) { return pg8::cvt_pk_bf16(lo, hi); }

__device__ __forceinline__ void retention_phase(LAS unsigned char* lds, const bf16_t* Q, const bf16_t* Kb, const bf16_t* V, bf16_t* RET, float* ssr) {
    const int tid = threadIdx.x, wid = __builtin_amdgcn_readfirstlane(tid >> 6), lane = tid & 63, fr = lane & 15, fq = lane >> 4;
    constexpr int QP = 528, VP = 80, PP = 144;
    constexpr int OFF_Q = 0, OFF_K = 33792, OFF_V = 67584, OFF_VD = 72704, OFF_P = 77824, OFF_ST = 87040, ST_BYTES = 16896;
    const unsigned lbase = (unsigned)(size_t)lds;
    const int trq = fr >> 2, trp = fr & 3;
    for (int item = blockIdx.x; item < 256; item += gridDim.x) {
        const int xcd = item & 7, loc = item >> 3, bh = xcd * 4 + (loc >> 3), js = loc & 7, b = bh >> 2, h = bh & 3;
        const float lg = log2f(1.0f - exp2f(-5.0f - (float)h));
        const float cdec = __builtin_amdgcn_exp2f(lg * 64.0f);
        __syncthreads();
        for (int i = tid; i < ST_BYTES / 4; i += 512) ((LAS unsigned*)(lds + OFF_ST))[i] = 0u;
        f32x4 sacc[2][2];
#pragma unroll
        for (int a = 0; a < 2; ++a)
#pragma unroll
            for (int c = 0; c < 2; ++c) sacc[a][c] = (f32x4){0.f, 0.f, 0.f, 0.f};
        const size_t tok0 = (size_t)b * SEQ;
        u32x4 rq[4], rk[4], rv;
#define RET_LOAD(c) do { _Pragma("unroll") for (int _i = 0; _i < 4; ++_i) { const int pc = tid + 512 * _i, row = pc >> 5, ch = pc & 31; const size_t e = (tok0 + 64 * (c) + row) * DM + h * 256 + ch * 8; \
            rq[_i] = *(const u32x4*)(Q + e); rk[_i] = *(const u32x4*)(Kb + e); } \
            if (tid < 256) { const int row = tid >> 2, ch = tid & 3; rv = *(const u32x4*)(V + (tok0 + 64 * (c) + row) * DM + h * 256 + js * 32 + ch * 8); } } while (0)
        RET_LOAD(0);
        for (int c = 0; c < 64; ++c) {
            __syncthreads();
#pragma unroll
            for (int i = 0; i < 4; ++i) { const int pc = tid + 512 * i, row = pc >> 5, ch = pc & 31;
                *(LAS u32x4*)(lds + OFF_Q + row * QP + ch * 16) = rq[i]; *(LAS u32x4*)(lds + OFF_K + row * QP + ch * 16) = rk[i]; }
            if (tid < 256) { const int row = tid >> 2, ch = tid & 3; *(LAS u32x4*)(lds + OFF_V + row * VP + ch * 16) = rv;
                const float kd = __builtin_amdgcn_exp2f(lg * (float)(63 - row)); f32x4 a0, a1; unpack8(rv, a0, a1); a0 *= kd; a1 *= kd;
                u32x4 w; w.x = pk2s(a0[0], a0[1]); w.y = pk2s(a0[2], a0[3]); w.z = pk2s(a1[0], a1[1]); w.w = pk2s(a1[2], a1[3]);
                *(LAS u32x4*)(lds + OFF_VD + row * VP + ch * 16) = w; }
            if (c + 1 < 64) RET_LOAD(c + 1);
            __syncthreads();
            bf16x8 qfc[8];
            {
                const int r = wid >> 1, kb0 = 2 * (wid & 1);
                f32x4 sT[2] = {(f32x4){0.f, 0.f, 0.f, 0.f}, (f32x4){0.f, 0.f, 0.f, 0.f}};
#pragma unroll
                for (int ks = 0; ks < 8; ++ks) {
                    const bf16x8 qf = *(const LAS bf16x8*)(lds + OFF_Q + (16 * r + fr) * QP + (32 * ks + 8 * fq) * 2); qfc[ks] = qf;
#pragma unroll
                    for (int j = 0; j < 2; ++j) { const bf16x8 kf = *(const LAS bf16x8*)(lds + OFF_K + (16 * (kb0 + j) + fr) * QP + (32 * ks + 8 * fq) * 2);
                        sT[j] = __builtin_amdgcn_mfma_f32_16x16x32_bf16(kf, qf, sT[j], 0, 0, 0); }
                }
                const int n = 16 * r + fr;
#pragma unroll
                for (int j = 0; j < 2; ++j) { const int m0 = 16 * (kb0 + j) + 4 * fq; float pv[4];
#pragma unroll
                    for (int i = 0; i < 4; ++i) { const int d = n - (m0 + i); pv[i] = sT[j][i] * __builtin_amdgcn_exp2f(lg * (float)(d < 0 ? -d : d)); }
                    u32x2 w; w.x = pk2s(pv[0], pv[1]); w.y = pk2s(pv[2], pv[3]);
                    *(LAS u32x2*)(lds + OFF_P + n * PP + m0 * 2) = w; }
            }
            {
#pragma unroll
                for (int a = 0; a < 2; ++a)
#pragma unroll
                    for (int cc = 0; cc < 2; ++cc) sacc[a][cc] *= cdec;
                {
                    const int r0 = 8 * fq + trq;
                    s16x4 ta[2][4], tb[2][4];
#pragma unroll
                    for (int a = 0; a < 2; ++a) tr4<0, 4 * QP, 32 * QP, 36 * QP>(lbase + OFF_K + r0 * QP + (16 * (2 * wid + a) + 4 * trp) * 2, ta[a][0], ta[a][1], ta[a][2], ta[a][3]);
#pragma unroll
                    for (int cc = 0; cc < 2; ++cc) tr4<0, 4 * VP, 32 * VP, 36 * VP>(lbase + OFF_VD + r0 * VP + (16 * cc + 4 * trp) * 2, tb[cc][0], tb[cc][1], tb[cc][2], tb[cc][3]);
                    tr_wait4(ta[0][0], ta[0][1], ta[0][2], ta[0][3]); tr_wait4(ta[1][0], ta[1][1], ta[1][2], ta[1][3]);
                    tr_wait4(tb[0][0], tb[0][1], tb[0][2], tb[0][3]); tr_wait4(tb[1][0], tb[1][1], tb[1][2], tb[1][3]);
#pragma unroll
                    for (int ks = 0; ks < 2; ++ks)
#pragma unroll
                        for (int a = 0; a < 2; ++a)
#pragma unroll
                            for (int cc = 0; cc < 2; ++cc) sacc[a][cc] = __builtin_amdgcn_mfma_f32_16x16x32_bf16(cat8(ta[a][2 * ks], ta[a][2 * ks + 1]), cat8(tb[cc][2 * ks], tb[cc][2 * ks + 1]), sacc[a][cc], 0, 0, 0);
                }
                LAS unsigned char* stn = lds + OFF_ST + ((c + 1) & 1) * ST_BYTES;
#pragma unroll
                for (int a = 0; a < 2; ++a)
#pragma unroll
                    for (int cc = 0; cc < 2; ++cc) { u32x2 w; w.x = pk2s(sacc[a][cc][0], sacc[a][cc][1]); w.y = pk2s(sacc[a][cc][2], sacc[a][cc][3]);
                        *(LAS u32x2*)(stn + (16 * cc + fr) * QP + (16 * (2 * wid + a) + 4 * fq) * 2) = w; }
            }
            __syncthreads();
            {
                const int r = wid >> 1, cb = wid & 1;
                f32x4 ain = (f32x4){0.f, 0.f, 0.f, 0.f}, acr = (f32x4){0.f, 0.f, 0.f, 0.f};
                {
                    s16x4 tv[4];
                    tr4<0, 4 * VP, 32 * VP, 36 * VP>(lbase + OFF_V + (8 * fq + trq) * VP + (16 * cb + 4 * trp) * 2, tv[0], tv[1], tv[2], tv[3]);
                    bf16x8 pf[2];
#pragma unroll
                    for (int ks = 0; ks < 2; ++ks) pf[ks] = *(const LAS bf16x8*)(lds + OFF_P + (16 * r + fr) * PP + (32 * ks + 8 * fq) * 2);
                    tr_wait4(tv[0], tv[1], tv[2], tv[3]);
#pragma unroll
                    for (int ks = 0; ks < 2; ++ks) ain = __builtin_amdgcn_mfma_f32_16x16x32_bf16(cat8(tv[2 * ks], tv[2 * ks + 1]), pf[ks], ain, 0, 0, 0);
                }
                const LAS unsigned char* stc = lds + OFF_ST + (c & 1) * ST_BYTES;
#pragma unroll
                for (int ks = 0; ks < 8; ++ks) {
                    const bf16x8 qf = qfc[ks];
                    const bf16x8 sf = *(const LAS bf16x8*)(stc + (16 * cb + fr) * QP + (32 * ks + 8 * fq) * 2);
                    acr = __builtin_amdgcn_mfma_f32_16x16x32_bf16(sf, qf, acr, 0, 0, 0);
                }
                const int n = 16 * r + fr; const float qd = __builtin_amdgcn_exp2f(lg * (float)(n + 1));
                const f32x4 o = ain + acr * qd;
                const size_t t = tok0 + 64 * c + n;
                u32x2 w; w.x = pk2s(o[0], o[1]); w.y = pk2s(o[2], o[3]);
                *(u32x2*)(RET + t * DM + h * 256 + js * 32 + cb * 16 + 4 * fq) = w;
                float q = (o[0] * o[0] + o[1] * o[1]) + (o[2] * o[2] + o[3] * o[3]);
                q += __shfl_xor(q, 16); q += __shfl_xor(q, 32);
                if (fq == 0) atomicAdd(ssr + t * 4 + h, q);
            }
        }
#undef RET_LOAD
    }
}

__device__ __forceinline__ void mix_elementwise(const bf16_t* RET, bf16_t* RN, const bf16_t* GR, const float* ssr, const bf16_t* P, bf16_t* PL) {
    const int gt = blockIdx.x * 512 + threadIdx.x, NGT = gridDim.x * 512;
    constexpr int T = 32;
    for (int item = gt; item < 128 * (MTOK / T); item += NGT) {
        const int ch = item & 127, g = ch >> 5, w = 2 << g; const size_t t0 = (size_t)(item >> 7) * T; const int pos0 = (int)(t0 & (SEQ - 1));
        const size_t base = t0 * DM + ch * 8;
        f32x4 s0 = (f32x4){0.f, 0.f, 0.f, 0.f}, s1 = s0;
        for (int k = 1; k < w; ++k) if (pos0 - k >= 0) { f32x4 b0, b1; unpack8(*(const u32x4*)(P + base - (size_t)k * DM), b0, b1); s0 += b0; s1 += b1; }
        u32x4 pc = *(const u32x4*)(P + base), rc = *(const u32x4*)(RET + base), gc = *(const u32x4*)(GR + base), oc = (u32x4){0u, 0u, 0u, 0u};
        float sq = ssr[t0 * 4 + g];
        if (pos0 + 1 >= w) oc = *(const u32x4*)(P + base - (size_t)(w - 1) * DM);
        for (int j = 0; j < T; ++j) {
            const size_t off = base + (size_t)j * DM; const int pos = pos0 + j;
            const u32x4 pcur = pc, rcur = rc, gcur = gc, ocur = oc; const float sqc = sq;
            if (j + 1 < T) { pc = *(const u32x4*)(P + off + DM); rc = *(const u32x4*)(RET + off + DM); gc = *(const u32x4*)(GR + off + DM); sq = ssr[(t0 + j + 1) * 4 + g];
                if (pos + 2 >= w) oc = *(const u32x4*)(P + off + DM - (size_t)(w - 1) * DM); }
            f32x4 c0, c1; unpack8(pcur, c0, c1); s0 += c0; s1 += c1;
            const int cnt = (pos + 1) < w ? (pos + 1) : w; const float inv = 1.0f / (float)cnt;
            *(u32x4*)(PL + off) = pack8(s0 * inv - c0, s1 * inv - c1);
            if (pos + 1 >= w) { f32x4 o0, o1; unpack8(ocur, o0, o1); s0 -= o0; s1 -= o1; }
            const float rs = __builtin_amdgcn_rsqf(sqc * (1.0f / 256.0f) + EPS);
            f32x4 a0, a1, g0, g1; unpack8(rcur, a0, a1); unpack8(gcur, g0, g1);
            *(u32x4*)(RN + off) = pack8(a0 * rs * g0, a1 * rs * g1);
        }
    }
}

__device__ __forceinline__ void final_norm(const bf16_t* hin, float* out, const float* ss, const float* g) {
    const size_t gt = (size_t)blockIdx.x * 512 + threadIdx.x, NGT = (size_t)gridDim.x * 512, NI = (size_t)MTOK * 128;
    u32x4 hn = (u32x4){0u, 0u, 0u, 0u}; float sn = 1.f;
    if (gt < NI) { hn = *(const u32x4*)(hin + (gt >> 7) * DM + (gt & 127) * 8); sn = ss[gt >> 7]; }
    for (size_t i = gt; i < NI; i += NGT) {
        const size_t t = i >> 7; const int c8 = (int)(i & 127) * 8; const u32x4 hc = hn; const float rs = rs_of(sn);
        const size_t i2 = i + NGT;
        if (i2 < NI) { hn = *(const u32x4*)(hin + (i2 >> 7) * DM + (i2 & 127) * 8); sn = ss[i2 >> 7]; }
        f32x4 v0, v1; unpack8(hc, v0, v1);
        const f32x4 g0 = *(const f32x4*)(g + c8), g1 = *(const f32x4*)(g + c8 + 4);
        *(f32x4*)(out + t * DM + c8) = v0 * rs * g0; *(f32x4*)(out + t * DM + c8 + 4) = v1 * rs * g1;
    }
}

#define XB_TMO      128
#define XB_XCNT(j)  (256  + 64 * (j))
#define XB_XSUB(j)  (1280 + 64 * (j))
#define XB_XGEN(j)  (2304 + 64 * (j))
#define XB_TOP      3328
#define XB_TOPGEN   3392
#define XCD_BAR_WORDS 3456
#define XB_SPIN_CAP (1u << 18)
__device__ __forceinline__ unsigned xb_ld(unsigned* p)              { return __hip_atomic_load(p, __ATOMIC_RELAXED, __HIP_MEMORY_SCOPE_AGENT); }
__device__ __forceinline__ unsigned xb_add(unsigned* p, unsigned v) { return __hip_atomic_fetch_add(p, v, __ATOMIC_RELAXED, __HIP_MEMORY_SCOPE_AGENT); }
__device__ __forceinline__ unsigned xb_xcc_id() { return (unsigned)__builtin_amdgcn_s_getreg((3 << 11) | 20) & 0xFu; }
#define XB_SPIN(cond, bar) do { unsigned _sp = 0; while (cond) { __builtin_amdgcn_s_sleep(1); \
    if ((++_sp & 255u) == 0u) { if (xb_ld(&(bar)[XB_TMO])) break; if (_sp > XB_SPIN_CAP) { atomicAdd(&(bar)[XB_TMO], 1u); break; } } } } while (0)
struct XcdBarrier { unsigned* bar; unsigned x; volatile LAS unsigned* st; };
__device__ __forceinline__ XcdBarrier xcd_barrier_post(unsigned* bar, volatile LAS unsigned* st) {
    XcdBarrier b; b.bar = bar; b.x = xb_xcc_id(); b.st = st;
    if (threadIdx.x == 0) (void)xb_add(&bar[XB_XCNT(b.x)], 1u);
    return b;
}
__device__ __forceinline__ void xcd_barrier_complete(unsigned* bar, unsigned x, unsigned& nloc, unsigned& nx) {
    const unsigned G = gridDim.x * gridDim.y * gridDim.z;
    unsigned sum, cnt, mine, sp = 0u;
    for (;;) {
        sum = 0u; cnt = 0u; mine = 0u;
#pragma unroll
        for (unsigned j = 0; j < 16; ++j) { const unsigned c = xb_ld(&bar[XB_XCNT(j)]); sum += c; cnt += (c > 0u) ? 1u : 0u; mine = (j == x) ? c : mine; }
        if (sum == G) break;
        __builtin_amdgcn_s_sleep(1);
        if ((++sp & 255u) == 0u) { if (xb_ld(&bar[XB_TMO])) break; if (sp > XB_SPIN_CAP) { atomicAdd(&bar[XB_TMO], 1u); break; } }
    }
    nloc = mine > 0u ? mine : 1u; nx = cnt > 0u ? cnt : 1u;
}
__device__ __forceinline__ void xcd_barrier(const XcdBarrier& b) {
    asm volatile("s_waitcnt vmcnt(0)" ::: "memory");
    __syncthreads();
    if (threadIdx.x == 0) {
        unsigned* bar = b.bar;
        __builtin_amdgcn_s_waitcnt(0);
        unsigned nloc = b.st[0], nx = b.st[1];
        if (nloc == 0u) { xcd_barrier_complete(bar, b.x, nloc, nx); b.st[0] = nloc; b.st[1] = nx; }
        const unsigned old = xb_add(&bar[XB_XSUB(b.x)], 1u);
        const unsigned gen = old / nloc;
        if (old + 1u == (gen + 1u) * nloc) {
            __builtin_amdgcn_fence(__ATOMIC_RELEASE, "agent");
            asm volatile("s_waitcnt vmcnt(0)" ::: "memory");
            const unsigned og = xb_add(&bar[XB_TOP], 1u);
            const unsigned tg = og / nx;
            if (og + 1u == (tg + 1u) * nx) xb_add(&bar[XB_TOPGEN], 1u);
            else XB_SPIN(xb_ld(&bar[XB_TOPGEN]) == tg, bar);
            __builtin_amdgcn_fence(__ATOMIC_ACQUIRE, "agent");
            xb_add(&bar[XB_XGEN(b.x)], 1u);
            asm volatile("s_waitcnt vmcnt(0)" ::: "memory");
        } else {
            XB_SPIN(xb_ld(&bar[XB_XGEN(b.x)]) == gen, bar);
            __builtin_amdgcn_fence(__ATOMIC_ACQUIRE, "agent");
            asm volatile("s_waitcnt vmcnt(0)" ::: "memory");
        }
    }
    __syncthreads();
}
constexpr size_t WS_BAR = 62 * MiB;

constexpr int NPHASE = 13;
__global__ void __launch_bounds__(512, 2) fwd_megakernel(Params p) {
    extern __shared__ __attribute__((aligned(16))) unsigned char lds_raw[];
    LAS unsigned char* lds = (LAS unsigned char*)lds_raw;
    unsigned char* ws = p.ws;
    const int G = gridDim.x, c = blockIdx.x;
    bf16_t* S0 = (bf16_t*)(ws + WS_S0); bf16_t* S1 = (bf16_t*)(ws + WS_S1); bf16_t* BIG = (bf16_t*)(ws + WS_BIG);
    bf16_t* B0 = BIG; bf16_t* B1 = BIG + SLOT / 2; bf16_t* B2 = BIG + SLOT; bf16_t* B3 = BIG + 3 * (SLOT / 2);
    float* ss1 = (float*)(ws + WS_SS1); float* ss2 = (float*)(ws + WS_SS2); float* ss3 = (float*)(ws + WS_SS3); float* ss4 = (float*)(ws + WS_SS4); float* ssr = (float*)(ws + WS_SSR);
    const int lo = p.ph_lo, hi = p.ph_hi;
    volatile LAS unsigned* xst = (volatile LAS unsigned*)(lds + pg8::STAGE_BYTES);
    if (threadIdx.x < 4) xst[threadIdx.x] = 0u;
    __syncthreads();
    XcdBarrier xbar = xcd_barrier_post((unsigned*)(ws + WS_BAR), xst);
    bf16_t* OLO = (bf16_t*)p.out; bf16_t* OHI = (bf16_t*)p.out + SLOT / 2;
#ifndef ENMASK
#define ENMASK 0x1fff
#endif
#define IN(k) (((ENMASK >> (k)) & 1) && lo <= (k) && (k) < hi)
    if (p.ph_hi < 0) cg::this_grid().sync();
#define SEAM(k) do { if (IN(k) && IN((k) + 1)) xcd_barrier(xbar); } while (0)
#ifndef REPMASK
#define REPMASK 0
#endif
#define NREP(k) (((REPMASK >> (k)) & 1) ? 2 : 1)
    float* dss = (float*)(ws + 60 * MiB); bf16_t* DUMB = (bf16_t*)(ws + 448 * MiB);
    if (IN(0)) for (int rep = NREP(0); rep > 0; --rep) p0_prologue(p, lds);
    SEAM(0);
    if (IN(1)) {
        pg8::Gemm g{S0, (const bf16_t*)(ws + WS_W1A), DM, DM, DM, 0}; pg8::StaticOrder S; S.init(MTOK, 2 * DFF, G, c, NREP(1));
        EpiSwiglu E{BIG, ss1}; pg8::gemm_phase(lds, g, S, E);
    }
    SEAM(1);
    if (IN(2)) {
        pg8::Gemm g{BIG, (const bf16_t*)(ws + WS_W1B), DFF, DFF, DFF, 0}; pg8::StaticOrder S; S.init(MTOK, DM, G, c, NREP(2));
        EpiResid<true> E{p.in[0], OLO, ss2, 0.5f, DUMB, dss}; pg8::gemm_phase(lds, g, S, E);
    }
    SEAM(2);
    bf16_t* S7 = (bf16_t*)(ws + 448 * MiB);
#define RUN_QKV() do { pg8::Gemm g{OLO, (const bf16_t*)(ws + WS_WIN), DM, DM, DM, 0}; pg8::StaticOrder S; S.init(MTOK, 3072, G, c, NREP(3)); \
            EpiQKV E{BIG, ss2, (const float*)(ws + WS_COS), (const float*)(ws + WS_SIN)}; pg8::gemm_phase(lds, g, S, E); } while (0)
#define RUN_GATES() do { pg8::Gemm g{OLO, (const bf16_t*)(ws + WS_WIN) + (size_t)3072 * DM, DM, DM, DM, 0}; pg8::StaticOrder S; S.init(MTOK, 4096, G, c, NREP(5)); \
            EpiGates E{ws, OHI, ss2, p.in[6]}; pg8::gemm_phase(lds, g, S, E); } while (0)
    if (IN(3)) RUN_QKV();
    SEAM(3);
    if (IN(4)) {
        if ((c >> 6) & 1) { RUN_GATES(); __syncthreads(); retention_phase(lds, B0, B1, B2, S0, ssr); }
        else { retention_phase(lds, B0, B1, B2, S0, ssr); __syncthreads(); RUN_GATES(); }
    }
#undef RUN_QKV
#undef RUN_GATES
    SEAM(4);
    if (IN(6)) for (int rep = NREP(6); rep > 0; --rep) mix_elementwise(S0, B0, B3, ssr, S1, B1);
    if (IN(5) && IN(6) && IN(7)) xcd_barrier(xbar);
    if (IN(7)) {
        {
            pg8::Gemm g{B1, (const bf16_t*)(ws + WS_WPL), DM, 256, 256, 256}; pg8::StaticOrder S; S.init(MTOK, DM, G, c, NREP(7));
            EpiScaleCol E{B2, p.in[8]}; pg8::gemm_phase(lds, g, S, E);
        }
        {
            pg8::Gemm g{B0, (const bf16_t*)(ws + WS_WRU), DM, DM, DM, 0}; pg8::StaticOrder S; S.init(MTOK, DM, G, c, NREP(7));
            EpiGateMul<false> E{S0, S7, nullptr}; pg8::gemm_phase(lds, g, S, E);
        }
    }
    SEAM(7);
    if (IN(8)) {
        pg8::Gemm g{B2, (const bf16_t*)(ws + WS_WPU), DM, DM, DM, 0}; pg8::StaticOrder S; S.init(MTOK, DM, G, c, NREP(8));
        EpiGateMul<true> E{S1, OHI, S0}; pg8::gemm_phase(lds, g, S, E);
    }
    SEAM(8);
    if (IN(9)) {
        pg8::Gemm g{S1, (const bf16_t*)(ws + WS_WO), DM, DM, DM, 0}; pg8::StaticOrder S; S.init(MTOK, DM, G, c, NREP(9));
        EpiResid<false> E{OLO, OHI, ss3, 1.0f, DUMB, dss}; pg8::gemm_phase(lds, g, S, E);
    }
    SEAM(9);
    if (IN(10)) {
        pg8::Gemm g{OHI, (const bf16_t*)(ws + WS_W2A), DM, DM, DM, 0}; pg8::StaticOrder S; S.init(MTOK, 2 * DFF, G, c, NREP(10));
        EpiSwiglu E{BIG, ss3}; pg8::gemm_phase(lds, g, S, E);
    }
    SEAM(10);
    if (IN(11)) {
        pg8::Gemm g{BIG, (const bf16_t*)(ws + WS_W2B), DFF, DFF, DFF, 0}; pg8::StaticOrder S; S.init(MTOK, DM, G, c, NREP(11));
        EpiResid<false> E{OHI, S1, ss4, 0.5f, DUMB, dss}; pg8::gemm_phase(lds, g, S, E);
    }
    SEAM(11);
    if (IN(12)) for (int rep = NREP(12); rep > 0; --rep) final_norm(S1, rep > 1 ? (float*)BIG : p.out, ss4, p.in[15]);
#undef IN
#undef SEAM
}

extern "C" void kernel_launch(void* const* d_in, const int* in_sizes, int n_in, void* d_out, int out_size, void* d_ws, size_t ws_size, hipStream_t stream) {
    constexpr int LDS_BYTES = pg8::STAGE_BYTES + 16;
    static int grid = 0;
    if (grid == 0) {
        if (n_in != 16 || out_size != MTOK * DM || ws_size < WS_END) { fprintf(stderr, "kernel_launch: unexpected shapes (n_in %d out %d ws %zu)\n", n_in, out_size, ws_size); grid = -1; return; }
        int dev = 0, cus = 0, per_cu = 0;
        (void)hipGetDevice(&dev); (void)hipDeviceGetAttribute(&cus, hipDeviceAttributeMultiprocessorCount, dev);
        if (hipFuncSetAttribute((const void*)fwd_megakernel, hipFuncAttributeMaxDynamicSharedMemorySize, LDS_BYTES) != hipSuccess) { fprintf(stderr, "kernel_launch: hipFuncSetAttribute failed\n"); grid = -1; return; }
        if (hipOccupancyMaxActiveBlocksPerMultiprocessor(&per_cu, (const void*)fwd_megakernel, 512, LDS_BYTES) != hipSuccess || per_cu < 1) { fprintf(stderr, "kernel_launch: occupancy query gave %d\n", per_cu); per_cu = 1; }
        (void)hipGetLastError();
        grid = cus;
    }
    if (grid < 0) return;
    if (hipMemsetAsync((char*)d_ws + WS_BAR, 0, XCD_BAR_WORDS * 4, stream) != hipSuccess) { fprintf(stderr, "kernel_launch: memset failed\n"); return; }
    Params p{};
    for (int i = 0; i < 16; ++i) p.in[i] = (const float*)d_in[i];
    p.out = (float*)d_out; p.ws = (unsigned char*)d_ws;
#if N_LAUNCH_MODE == 1
    p.ph_lo = 0; p.ph_hi = NPHASE;
    void* args[] = {&p};
    hipError_t e = hipLaunchCooperativeKernel((const void*)fwd_megakernel, dim3(grid), dim3(512), args, LDS_BYTES, stream);
    if (e != hipSuccess) fprintf(stderr, "cooperative launch failed: %s (grid %d)\n", hipGetErrorString(e), grid);
#else
    for (int ph = 0; ph < NPHASE; ++ph) { p.ph_lo = ph; p.ph_hi = ph + 1; hipLaunchKernelGGL(fwd_megakernel, dim3(grid), dim3(512), LDS_BYTES, stream, p); }
#endif
}
```

```cpp
#include <hip/hip_runtime.h>
#include <hip/hip_cooperative_groups.h>
#include <cstdio>
namespace cg = cooperative_groups;

#ifndef N_LAUNCH_MODE
#define N_LAUNCH_MODE 1
#endif

#define LAS __attribute__((address_space(3)))
typedef unsigned short bf16_t;
typedef short bf16x8 __attribute__((ext_vector_type(8)));
typedef short s16x4 __attribute__((ext_vector_type(4)));
typedef float f32x4 __attribute__((ext_vector_type(4)));
typedef unsigned u32x4 __attribute__((ext_vector_type(4)));
typedef unsigned u32x2 __attribute__((ext_vector_type(2)));

constexpr int MTOK = 32768, DM = 1024, DFF = 2816, SEQ = 4096, NIN = 7168;
constexpr float EPS = 1e-6f;

constexpr size_t MiB = 1024ull * 1024ull;
constexpr size_t WS_W1A = 0;
constexpr size_t WS_W1B = WS_W1A + 5632ull * 1024 * 2;
constexpr size_t WS_WIN = WS_W1B + 1024ull * 2816 * 2;
constexpr size_t WS_WPL = WS_WIN + 7168ull * 1024 * 2;
constexpr size_t WS_WRU = WS_WPL + 1024ull * 256 * 2;
constexpr size_t WS_WPU = WS_WRU + 1024ull * 1024 * 2;
constexpr size_t WS_WO  = WS_WPU + 1024ull * 1024 * 2;
constexpr size_t WS_W2A = WS_WO + 1024ull * 1024 * 2;
constexpr size_t WS_W2B = WS_W2A + 5632ull * 1024 * 2;
constexpr size_t WS_COS = WS_W2B + 1024ull * 2816 * 2;
constexpr size_t WS_SIN = WS_COS + 4096ull * 128 * 4;
constexpr size_t WS_SS1 = WS_SIN + 4096ull * 128 * 4;
constexpr size_t WS_SS2 = WS_SS1 + MTOK * 4ull;
constexpr size_t WS_SS3 = WS_SS2 + MTOK * 4ull;
constexpr size_t WS_SS4 = WS_SS3 + MTOK * 4ull;
constexpr size_t WS_SSR = WS_SS4 + MTOK * 4ull;
constexpr size_t WS_SMALL_END = WS_SSR + MTOK * 16ull;
static_assert(WS_SMALL_END <= 64 * MiB, "weights region");
constexpr size_t WS_S0 = 64 * MiB;
constexpr size_t WS_S1 = 128 * MiB;
constexpr size_t WS_BIG = 192 * MiB;
constexpr size_t WS_END = 512 * MiB;
constexpr size_t SLOT = 64 * MiB;

namespace pg8 {
constexpr int BM = 256, BK = 64, HALF = 128, HTB = HALF * BK * 2, STAGE_BYTES = 8 * HTB, NXCD = 8, WGM = 8;
__host__ __device__ __forceinline__ int lds_byte(int r, int c) { const int st = (r >> 4) * 2 + (c >> 5), rr = r & 15, cc = c & 31, ob = rr * 64 + cc * 2; return st * 1024 + (ob ^ (((ob >> 9) & 1) << 5)); }
__host__ __device__ __forceinline__ void stage_rc(int b, int& R, int& C) { const int st = b / 1024, sb = b % 1024, swz = sb ^ (((sb >> 9) & 1) << 5); R = (st >> 1) * 16 + swz / 64; C = (st & 1) * 32 + (swz % 64) / 2; }
__host__ __device__ __forceinline__ int perm32(int rho) { const int n = rho >> 4, i = rho & 15; return 8 * (i >> 2) + 4 * n + (i & 3); }

struct Unit { int pm, pn, pass; };
struct Gemm { const bf16_t* A; const bf16_t* Bt; int lda, ldb, K; int a_pn_off; };

struct StaticOrder {
    int nM, nN, nwg, G, c, rept;
    __host__ __device__ void init(int M, int N, int G_, int c_, int rept_ = 1) { nM = M / BM; nN = N / BM; nwg = nM * nN; G = G_; c = c_; rept = rept_; }
    __host__ __device__ bool next(int i, Unit& u) const {
        u.pass = 0;
        if (rept > 1) { const int ni = (nwg - c + G - 1) / G; if (ni <= 0 || i >= ni * rept) return false; u.pass = rept - 1 - i / ni; i = i % ni; }
        const long L = (long)i * G + c; if (L >= nwg) return false;
        int wgid = (int)L; { const int q = nwg / NXCD, r = nwg % NXCD, xcd = wgid % NXCD, off = wgid / NXCD; wgid = (xcd < r ? xcd * (q + 1) : r * (q + 1) + (xcd - r) * q) + off; }
        const int nig = WGM * nN, gid = wgid / nig, fm = gid * WGM, gsz = (nM - fm) < WGM ? (nM - fm) : WGM;
        u.pm = fm + ((wgid % nig) % gsz); u.pn = (wgid % nig) / gsz; return true;
    }
};
typedef float f32x2_t __attribute__((ext_vector_type(2)));
typedef __bf16 bf16x2_t __attribute__((ext_vector_type(2)));
__device__ __forceinline__ unsigned cvt_pk_bf16(float lo, float hi) { f32x2_t v = {lo, hi}; bf16x2_t b = __builtin_convertvector(v, bf16x2_t); return __builtin_bit_cast(unsigned, b); }

template <class Epi>
__device__ __forceinline__ void gemm_phase(LAS unsigned char* lds, const Gemm g, const StaticOrder& S, const Epi& E) {
    const int tid = threadIdx.x, wid = __builtin_amdgcn_readfirstlane(tid >> 6), lane = tid & 63, wr = wid >> 2, wc = wid & 3, fr = lane & 15, fq = lane >> 4;
    const int K = g.K, nt = K / BK;
    unsigned voffA[2], voffB[2];
#pragma unroll
    for (int i = 0; i < 2; ++i) { int R, C; stage_rc(tid * 16 + i * 8192, R, C); const int Rb = Epi::PERM ? ((R & ~31) + perm32(R & 31)) : R;
        voffA[i] = (unsigned)(R * g.lda + C) * 2u; voffB[i] = (unsigned)(Rb * g.ldb + C) * 2u; }
    const size_t kstep = (size_t)(BK * 2);
    const size_t hstepA = (size_t)HALF * g.lda * 2, hstepB = (size_t)HALF * g.ldb * 2;
    const size_t tstepA = 2 * hstepA, tstepB = 2 * hstepB;
    const unsigned ldsw = (unsigned)wid * 1024u;
    const int aoff = lds_byte(wr * 64 + fr, fq * 8), boff = lds_byte(wc * 32 + fr, fq * 8);
#define PG8_SA(b, h) (((b) * 2 + (h)) * HTB)
#define PG8_SB(b, h) ((4 + (b) * 2 + (h)) * HTB)
#define PG8_STAGE(bufoff, gbase, voff) do { _Pragma("unroll") for (int _i = 0; _i < 2; ++_i) \
        __builtin_amdgcn_global_load_lds((const unsigned*)((const char*)(gbase) + (voff)[_i]), (LAS unsigned*)(lds + (bufoff) + ldsw + _i * 8192), 16, 0, 0); } while (0)
#define PG8_LDA(dst, b, h) do { _Pragma("unroll") for (int m = 0; m < 4; ++m) _Pragma("unroll") for (int k = 0; k < 2; ++k) dst[m][k] = *(const LAS bf16x8*)(lds + PG8_SA(b, h) + aoff + m * 2048 + k * 1024); } while (0)
#define PG8_LDB(dst, b, h) do { _Pragma("unroll") for (int n = 0; n < 2; ++n) _Pragma("unroll") for (int k = 0; k < 2; ++k) dst[n][k] = *(const LAS bf16x8*)(lds + PG8_SB(b, h) + boff + n * 2048 + k * 1024); } while (0)
#define PG8_MMA(ai, bj, At, Bt) do { __builtin_amdgcn_s_setprio(1); _Pragma("unroll") for (int m = 0; m < 4; ++m) _Pragma("unroll") for (int n = 0; n < 2; ++n) _Pragma("unroll") for (int k = 0; k < 2; ++k) \
        acc[ai][bj][m][n] = __builtin_amdgcn_mfma_f32_16x16x32_bf16(Bt[n][k], At[m][k], acc[ai][bj][m][n], 0, 0, 0); __builtin_amdgcn_s_setprio(0); } while (0)
#define PG8_WAIT_V(n) asm volatile("s_waitcnt vmcnt(" #n ")" ::: "memory")
#define PG8_WAIT_L(n) asm volatile("s_waitcnt lgkmcnt(" #n ")" ::: "memory")
#define PG8_BAR __builtin_amdgcn_s_barrier()
#define PG8_SCHED __builtin_amdgcn_sched_barrier(0)
    Unit cur, nxt; int ui = 0;
    if (!S.next(0, cur)) return;
    typename Epi::Pre pre;
    f32x4 acc[2][2][4][2];
#pragma unroll
    for (int a = 0; a < 2; ++a)
#pragma unroll
        for (int b = 0; b < 2; ++b)
#pragma unroll
            for (int m = 0; m < 4; ++m)
#pragma unroll
                for (int n = 0; n < 2; ++n) acc[a][b][m][n] = (f32x4){0.f, 0.f, 0.f, 0.f};
    bf16x8 At[4][2], B0[2][2], B1[2][2];
    const char* cA = (const char*)g.A + (size_t)cur.pm * tstepA + (size_t)cur.pn * g.a_pn_off * 2; const char* cB = (const char*)g.Bt + (size_t)cur.pn * tstepB;
    PG8_STAGE(PG8_SB(0, 0), cB, voffB); PG8_STAGE(PG8_SB(0, 1), cB + hstepB, voffB); PG8_STAGE(PG8_SA(0, 0), cA, voffA); PG8_STAGE(PG8_SA(0, 1), cA + hstepA, voffA);
    if (wr == 1) PG8_BAR;
    PG8_WAIT_V(2); PG8_BAR;
    PG8_STAGE(PG8_SB(1, 0), cB + kstep, voffB); PG8_STAGE(PG8_SA(1, 0), cA + kstep, voffA); PG8_STAGE(PG8_SB(1, 1), cB + hstepB + kstep, voffB);
    PG8_WAIT_V(6); PG8_BAR;
    for (;;) {
        const bool has_next = S.next(ui + 1, nxt);
        const char* nA = has_next ? (const char*)g.A + (size_t)nxt.pm * tstepA + (size_t)nxt.pn * g.a_pn_off * 2 : cA; const char* nB = has_next ? (const char*)g.Bt + (size_t)nxt.pn * tstepB : cB;
#pragma unroll 1
        for (int t = 0; t < nt; t += 2) {
            const bool last = (t == nt - 2);
            const char* a1 = cA + (size_t)(t + 1) * kstep;
            const char* a2 = last ? nA : cA + (size_t)(t + 2) * kstep; const char* b2 = last ? nB : cB + (size_t)(t + 2) * kstep;
            const char* a3 = a2 + kstep; const char* b3 = b2 + kstep;
            if (last) E.prefetch(pre, cur, wr, wc, fr, fq);
            PG8_LDB(B0, 0, 0); PG8_LDB(B1, 0, 1); PG8_SCHED; PG8_LDA(At, 0, 0); PG8_STAGE(PG8_SA(1, 1), a1 + hstepA, voffA);
            PG8_WAIT_V(8); PG8_WAIT_L(0); PG8_BAR; PG8_MMA(0, 0, At, B0); PG8_MMA(0, 1, At, B1); PG8_BAR; PG8_SCHED;
            PG8_LDA(At, 0, 1); PG8_STAGE(PG8_SB(0, 0), b2, voffB); PG8_STAGE(PG8_SB(0, 1), b2 + hstepB, voffB); PG8_STAGE(PG8_SA(0, 0), a2, voffA);
            PG8_WAIT_V(8); PG8_WAIT_L(0); PG8_BAR; PG8_MMA(1, 0, At, B0); PG8_MMA(1, 1, At, B1); PG8_BAR; PG8_SCHED;
            PG8_LDB(B0, 1, 0); PG8_LDB(B1, 1, 1); PG8_SCHED; PG8_LDA(At, 1, 0); PG8_STAGE(PG8_SA(0, 1), a2 + hstepA, voffA);
            PG8_WAIT_V(8); PG8_WAIT_L(0); PG8_BAR; PG8_MMA(0, 0, At, B0); PG8_MMA(0, 1, At, B1); PG8_BAR; PG8_SCHED;
            PG8_LDA(At, 1, 1); PG8_STAGE(PG8_SB(1, 0), b3, voffB); PG8_STAGE(PG8_SB(1, 1), b3 + hstepB, voffB); PG8_STAGE(PG8_SA(1, 0), a3, voffA);
            PG8_WAIT_V(8); PG8_WAIT_L(0); PG8_BAR; PG8_MMA(1, 0, At, B0); PG8_MMA(1, 1, At, B1); PG8_BAR; PG8_SCHED;
        }
        if (wr == 0) PG8_BAR;
        E(acc, pre, cur, wr, wc, fr, fq);
        if (wr == 1) PG8_BAR;
        if (!has_next) break;
#pragma unroll
        for (int a = 0; a < 2; ++a)
#pragma unroll
            for (int b = 0; b < 2; ++b)
#pragma unroll
                for (int m = 0; m < 4; ++m)
#pragma unroll
                    for (int n = 0; n < 2; ++n) acc[a][b][m][n] = (f32x4){0.f, 0.f, 0.f, 0.f};
        cur = nxt; cA = nA; cB = nB; ++ui;
    }
    PG8_WAIT_V(0);
    if (wr == 0) PG8_BAR;
    PG8_BAR;
#undef PG8_SA
#undef PG8_SB
#undef PG8_STAGE
#undef PG8_LDA
#undef PG8_LDB
#undef PG8_MMA
#undef PG8_WAIT_V
#undef PG8_WAIT_L
#undef PG8_BAR
#undef PG8_SCHED
}
}
using pg8::cvt_pk_bf16;
using pg8::Unit;

__device__ __forceinline__ float sigm_f(float g) { return __builtin_amdgcn_rcpf(1.0f + __builtin_amdgcn_exp2f(g * -1.4426950408889634f)); }
__device__ __forceinline__ float silu_f(float g) { return g * sigm_f(g); }
__device__ __forceinline__ f32x4 sigm4(const f32x4 g) { const f32x4 a = g * -1.4426950408889634f; f32x4 e; e[0] = __builtin_amdgcn_exp2f(a[0]); e[1] = __builtin_amdgcn_exp2f(a[1]); e[2] = __builtin_amdgcn_exp2f(a[2]); e[3] = __builtin_amdgcn_exp2f(a[3]);
    const f32x4 d = e + 1.0f; f32x4 r; r[0] = __builtin_amdgcn_rcpf(d[0]); r[1] = __builtin_amdgcn_rcpf(d[1]); r[2] = __builtin_amdgcn_rcpf(d[2]); r[3] = __builtin_amdgcn_rcpf(d[3]); return r; }
__device__ __forceinline__ float rs_of(float ss) { return __builtin_amdgcn_rsqf(ss * (1.0f / 1024.0f) + EPS); }
__device__ __forceinline__ float bf2f(unsigned short b) { return __uint_as_float(((unsigned)b) << 16); }
__device__ __forceinline__ u32x4 pack8(const f32x4 a, const f32x4 b) { u32x4 w; w.x = cvt_pk_bf16(a[0], a[1]); w.y = cvt_pk_bf16(a[2], a[3]); w.z = cvt_pk_bf16(b[0], b[1]); w.w = cvt_pk_bf16(b[2], b[3]); return w; }
__device__ __forceinline__ void unpack8(const u32x4 w, f32x4& a, f32x4& b) {
    a[0] = __uint_as_float(w.x << 16); a[1] = __uint_as_float(w.x & 0xffff0000u); a[2] = __uint_as_float(w.y << 16); a[3] = __uint_as_float(w.y & 0xffff0000u);
    b[0] = __uint_as_float(w.z << 16); b[1] = __uint_as_float(w.z & 0xffff0000u); b[2] = __uint_as_float(w.w << 16); b[3] = __uint_as_float(w.w & 0xffff0000u); }

#define ROWOF(ri) (row0 + ((ri) >> 2) * 128 + ((ri) & 3) * 16)
#define ACC(ri, bj, n) acc[(ri) >> 2][bj][(ri) & 3][n]
struct EpiSwiglu {
    static constexpr bool PERM = true;
    struct Pre {};
    __device__ __forceinline__ void prefetch(Pre&, const Unit&, int, int, int, int) const {}
    bf16_t* O; const float* ss;
    __device__ __forceinline__ void operator()(const f32x4 (&acc)[2][2][4][2], Pre& pre, const Unit& u, int wr, int wc, int fr, int fq) const {
        const int row0 = u.pm * 256 + wr * 64 + fr, col0 = u.pn * 128 + wc * 32 + 8 * fq;
        float ssv[8];
#pragma unroll
        for (int ri = 0; ri < 8; ++ri) ssv[ri] = ss[ROWOF(ri)];
#pragma unroll
        for (int ri = 0; ri < 8; ++ri) { const int r = ROWOF(ri); const float rs = rs_of(ssv[ri]);
            f32x4 o[2];
#pragma unroll
            for (int n = 0; n < 2; ++n) { const f32x4 gt = ACC(ri, 0, n) * rs, up = ACC(ri, 1, n) * rs; o[n] = (gt * up) * sigm4(gt); }
            *(u32x4*)(O + (size_t)r * DFF + col0) = pack8(o[0], o[1]); }
    }
};
template <bool IN_F32> struct EpiResid {
    static constexpr bool PERM = true;
    struct Pre {};
    __device__ __forceinline__ void prefetch(Pre&, const Unit&, int, int, int, int) const {}
    const void* hin; bf16_t* hb_; float* ss_; float scale; bf16_t* hb_d; float* ss_d;
    __device__ __forceinline__ void ldrow(size_t off, f32x4 (&b)[2][2]) const {
#pragma unroll
        for (int bj = 0; bj < 2; ++bj) {
            if (IN_F32) { b[bj][0] = *(const f32x4*)((const float*)hin + off + bj * 128); b[bj][1] = *(const f32x4*)((const float*)hin + off + bj * 128 + 4); }
            else unpack8(*(const u32x4*)((const bf16_t*)hin + off + bj * 128), b[bj][0], b[bj][1]); }
    }
    __device__ __forceinline__ void operator()(const f32x4 (&acc)[2][2][4][2], Pre& pre, const Unit& u, int wr, int wc, int fr, int fq) const {
        bf16_t* hb = hb_; float* ss = ss_;
        if (u.pass > 0) { hb = hb_d; ss = ss_d; }
        const int row0 = u.pm * 256 + wr * 64 + fr, col0 = u.pn * 256 + wc * 32 + 8 * fq;
        f32x4 bb[2][2][2];
        ldrow((size_t)ROWOF(0) * DM + col0, bb[0]);
#pragma unroll
        for (int ri = 0; ri < 8; ++ri) { const int r = ROWOF(ri); const size_t off = (size_t)r * DM + col0; float q = 0.f;
            if (ri < 7) ldrow((size_t)ROWOF(ri + 1) * DM + col0, bb[(ri + 1) & 1]);
#pragma unroll
            for (int bj = 0; bj < 2; ++bj) {
                const f32x4 o0 = bb[ri & 1][bj][0] + ACC(ri, bj, 0) * scale, o1 = bb[ri & 1][bj][1] + ACC(ri, bj, 1) * scale;
                *(u32x4*)(hb + off + bj * 128) = pack8(o0, o1);
                q += ((o0[0] * o0[0] + o0[1] * o0[1]) + (o0[2] * o0[2] + o0[3] * o0[3])) + ((o1[0] * o1[0] + o1[1] * o1[1]) + (o1[2] * o1[2] + o1[3] * o1[3])); }
            q += __shfl_xor(q, 16); q += __shfl_xor(q, 32);
            if (fq == 0) atomicAdd(ss + r, q); }
    }
};
struct EpiQKV {
    static constexpr bool PERM = true;
    struct Pre {};
    __device__ __forceinline__ void prefetch(Pre&, const Unit&, int, int, int, int) const {}
    bf16_t* QKV; const float* ss; const float* cosT; const float* sinT;
    __device__ __forceinline__ void operator()(const f32x4 (&acc)[2][2][4][2], Pre& pre, const Unit& u, int wr, int wc, int fr, int fq) const {
        const int sect = u.pn >> 2, hd = u.pn & 3; bf16_t* base = QKV + (size_t)sect * (SLOT / 2);
        const int row0 = u.pm * 256 + wr * 64 + fr, j0 = wc * 32 + 8 * fq; const float ksc = sect == 1 ? 0.0625f : 1.0f;
        float ssv[8];
#pragma unroll
        for (int ri = 0; ri < 8; ++ri) ssv[ri] = ss[ROWOF(ri)];
        f32x4 cs[2][2][2];
#pragma unroll
        for (int n = 0; n < 2; ++n) { cs[0][0][n] = (f32x4){1.f, 1.f, 1.f, 1.f}; cs[0][1][n] = (f32x4){0.f, 0.f, 0.f, 0.f}; cs[1][0][n] = cs[0][0][n]; cs[1][1][n] = cs[0][1][n]; }
        if (sect < 2) { const int pos = ROWOF(0) & (SEQ - 1);
#pragma unroll
            for (int n = 0; n < 2; ++n) { cs[0][0][n] = *(const f32x4*)(cosT + pos * 128 + j0 + 4 * n); cs[0][1][n] = *(const f32x4*)(sinT + pos * 128 + j0 + 4 * n); } }
#pragma unroll
        for (int ri = 0; ri < 8; ++ri) { const int r = ROWOF(ri); const float rs = rs_of(ssv[ri]);
            if (ri < 7 && sect < 2) { const int pos = ROWOF(ri + 1) & (SEQ - 1);
#pragma unroll
                for (int n = 0; n < 2; ++n) { cs[(ri + 1) & 1][0][n] = *(const f32x4*)(cosT + pos * 128 + j0 + 4 * n); cs[(ri + 1) & 1][1][n] = *(const f32x4*)(sinT + pos * 128 + j0 + 4 * n); } }
            f32x4 o1[2], o2[2];
#pragma unroll
            for (int n = 0; n < 2; ++n) { const f32x4 c = cs[ri & 1][0][n], sn = cs[ri & 1][1][n];
                const f32x4 x1 = ACC(ri, 0, n) * rs, x2 = ACC(ri, 1, n) * rs; o1[n] = (x1 * c - x2 * sn) * ksc; o2[n] = (x1 * sn + x2 * c) * ksc; }
            bf16_t* rp = base + (size_t)r * DM + hd * 256 + j0;
            *(u32x4*)(rp) = pack8(o1[0], o1[1]); *(u32x4*)(rp + 128) = pack8(o2[0], o2[1]); }
    }
};
struct EpiGates {
    static constexpr bool PERM = true;
    struct Pre {};
    __device__ __forceinline__ void prefetch(Pre&, const Unit&, int, int, int, int) const {}
    unsigned char* wsb; bf16_t* ohi; const float* ss; const float* gbias; int pn0;
    __device__ __forceinline__ void operator()(const f32x4 (&acc)[2][2][4][2], Pre& pre, const Unit& u, int wr, int wc, int fr, int fq) const {
        const int pnn = u.pn + pn0, sect = pnn >> 2, ct = (pnn & 3) * 256; bf16_t* O = sect == 3 ? ohi : (bf16_t*)(wsb + (size_t)((0x726u >> (4 * sect)) & 0xFu) * SLOT);
        const int row0 = u.pm * 256 + wr * 64 + fr, c0 = ct + wc * 32 + 8 * fq;
        float ssv[8];
#pragma unroll
        for (int ri = 0; ri < 8; ++ri) ssv[ri] = ss[ROWOF(ri)];
        f32x4 bv[2][2];
#pragma unroll
        for (int bj = 0; bj < 2; ++bj)
#pragma unroll
            for (int n = 0; n < 2; ++n) bv[bj][n] = sect >= 2 ? *(const f32x4*)(gbias + (sect - 2) * DM + c0 + bj * 128 + 4 * n) : (f32x4){0.f, 0.f, 0.f, 0.f};
#pragma unroll
        for (int ri = 0; ri < 8; ++ri) { const int r = ROWOF(ri); const float rs = rs_of(ssv[ri]);
#pragma unroll
            for (int bj = 0; bj < 2; ++bj) { f32x4 o[2];
#pragma unroll
                for (int n = 0; n < 2; ++n) { const f32x4 v = ACC(ri, bj, n) * rs + bv[bj][n]; o[n] = v; if (sect != 1) { const f32x4 sg = sigm4(v); o[n] = sect == 0 ? v * sg : sg; } }
                *(u32x4*)(O + (size_t)r * DM + c0 + bj * 128) = pack8(o[0], o[1]); } }
    }
};
struct EpiScaleCol {
    static constexpr bool PERM = true;
    struct Pre {};
    __device__ __forceinline__ void prefetch(Pre&, const Unit&, int, int, int, int) const {}
    bf16_t* O; const float* scale;
    __device__ __forceinline__ void operator()(const f32x4 (&acc)[2][2][4][2], Pre& pre, const Unit& u, int wr, int wc, int fr, int fq) const {
        const int row0 = u.pm * 256 + wr * 64 + fr, c0 = u.pn * 256 + wc * 32 + 8 * fq;
        f32x4 sv[2][2];
#pragma unroll
        for (int bj = 0; bj < 2; ++bj)
#pragma unroll
            for (int n = 0; n < 2; ++n) sv[bj][n] = *(const f32x4*)(scale + c0 + bj * 128 + 4 * n);
#pragma unroll
        for (int ri = 0; ri < 8; ++ri) { const int r = ROWOF(ri);
#pragma unroll
            for (int bj = 0; bj < 2; ++bj) *(u32x4*)(O + (size_t)r * DM + c0 + bj * 128) = pack8(ACC(ri, bj, 0) * sv[bj][0], ACC(ri, bj, 1) * sv[bj][1]); }
    }
};
template <bool ADD> struct EpiGateMul {
    static constexpr bool PERM = true;
    struct Pre {};
    __device__ __forceinline__ void prefetch(Pre&, const Unit&, int, int, int, int) const {}
    bf16_t* O; const bf16_t* G; const bf16_t* Min;
    __device__ __forceinline__ void ldrow(size_t off, u32x4 (&g)[2], u32x4 (&a)[2]) const {
#pragma unroll
        for (int bj = 0; bj < 2; ++bj) { g[bj] = *(const u32x4*)(G + off + bj * 128); if (ADD) a[bj] = *(const u32x4*)(Min + off + bj * 128); }
    }
    __device__ __forceinline__ void operator()(const f32x4 (&acc)[2][2][4][2], Pre& pre, const Unit& u, int wr, int wc, int fr, int fq) const {
        const int row0 = u.pm * 256 + wr * 64 + fr, c0 = u.pn * 256 + wc * 32 + 8 * fq;
        u32x4 gb[2][2], ab[2][2];
        ldrow((size_t)ROWOF(0) * DM + c0, gb[0], ab[0]);
#pragma unroll
        for (int ri = 0; ri < 8; ++ri) { const size_t off = (size_t)ROWOF(ri) * DM + c0;
            if (ri < 7) ldrow((size_t)ROWOF(ri + 1) * DM + c0, gb[(ri + 1) & 1], ab[(ri + 1) & 1]);
#pragma unroll
            for (int bj = 0; bj < 2; ++bj) {
                f32x4 g0, g1; unpack8(gb[ri & 1][bj], g0, g1);
                f32x4 o0 = g0 * ACC(ri, bj, 0), o1 = g1 * ACC(ri, bj, 1);
                if (ADD) { f32x4 a0, a1; unpack8(ab[ri & 1][bj], a0, a1); o0 += a0; o1 += a1; }
                *(u32x4*)(O + off + bj * 128) = pack8(o0, o1); } }
    }
};

__device__ __forceinline__ unsigned pk2(float lo, float hi) { return cvt_pk_bf16(lo, hi); }
template <int MODE>
__device__ __forceinline__ void p0_transpose_item(const float* W, int ldw, bf16_t* WT, int ldt, int nblk, const float* gain, LAS float* scr, int item, int lane) {
    const int kb = item / nblk, nb = item % nblk, k0 = 64 * kb, n0 = 32 * nb;
    int sc0 = n0;
    if (MODE == 1) { const int tile = n0 >> 8, r = n0 & 255; sc0 = (r >> 7) * DFF + 128 * tile + (r & 127); }
    f32x4 v[8]; float gv[8];
#pragma unroll
    for (int i = 0; i < 8; ++i) { const int kk = 8 * i + (lane >> 3); v[i] = *(const f32x4*)(W + (size_t)(k0 + kk) * ldw + sc0 + (lane & 7) * 4); gv[i] = gain ? gain[k0 + kk] : 1.0f; }
#pragma unroll
    for (int i = 0; i < 8; ++i) { const int kk = 8 * i + (lane >> 3); LAS float* d = scr + kk * 33 + (lane & 7) * 4;
        d[0] = v[i][0] * gv[i]; d[1] = v[i][1] * gv[i]; d[2] = v[i][2] * gv[i]; d[3] = v[i][3] * gv[i]; }
    asm volatile("s_waitcnt lgkmcnt(0)" ::: "memory");
    const int c = lane & 7;
#pragma unroll
    for (int j = 0; j < 4; ++j) { const int n = (lane >> 3) + 8 * j; const LAS float* s = scr + (8 * c) * 33 + n;
        u32x4 o; o.x = pk2(s[0 * 33], s[1 * 33]); o.y = pk2(s[2 * 33], s[3 * 33]); o.z = pk2(s[4 * 33], s[5 * 33]); o.w = pk2(s[6 * 33], s[7 * 33]);
        *(u32x4*)(WT + (size_t)(n0 + n) * ldt + k0 + 8 * c) = o; }
    asm volatile("s_waitcnt lgkmcnt(0)" ::: "memory");
}

struct Params {
    const float* in[16];
    float* out; unsigned char* ws;
    int ph_lo, ph_hi;
};

__device__ __forceinline__ void p0_prologue(const Params& p, LAS unsigned char* lds) {
    const int tid = threadIdx.x, lane = tid & 63, wave = tid >> 6;
    const int G = gridDim.x, gw = blockIdx.x * 8 + wave, NGW = G * 8;
    unsigned char* ws = p.ws;
    LAS float* scr = (LAS float*)(lds + wave * 16384);
    constexpr int I_1A = 16 * 176, I_1B = 44 * 32, I_IN = 16 * 224, I_PL = 4 * 32, I_SQ = 16 * 32;
    constexpr int NITEMS = 2 * I_1A + 2 * I_1B + I_IN + I_PL + 3 * I_SQ;
    for (int it = gw; it < NITEMS; it += NGW) {
        int r = it;
        if (r < I_1A) { p0_transpose_item<1>(p.in[2], 2 * DFF, (bf16_t*)(ws + WS_W1A), DM, 176, p.in[1], scr, r, lane); continue; } r -= I_1A;
        if (r < I_1A) { p0_transpose_item<1>(p.in[13], 2 * DFF, (bf16_t*)(ws + WS_W2A), DM, 176, p.in[12], scr, r, lane); continue; } r -= I_1A;
        if (r < I_1B) { p0_transpose_item<0>(p.in[3], DM, (bf16_t*)(ws + WS_W1B), DFF, 32, nullptr, scr, r, lane); continue; } r -= I_1B;
        if (r < I_1B) { p0_transpose_item<0>(p.in[14], DM, (bf16_t*)(ws + WS_W2B), DFF, 32, nullptr, scr, r, lane); continue; } r -= I_1B;
        if (r < I_IN) { p0_transpose_item<0>(p.in[5], NIN, (bf16_t*)(ws + WS_WIN), DM, 224, p.in[4], scr, r, lane); continue; } r -= I_IN;
        if (r < I_PL) { const int g = r >> 5; p0_transpose_item<0>(p.in[7] + (size_t)g * 65536, 256, (bf16_t*)(ws + WS_WPL) + (size_t)g * 65536, 256, 8, nullptr, scr, r & 31, lane); continue; } r -= I_PL;
        if (r < I_SQ) { p0_transpose_item<0>(p.in[9], DM, (bf16_t*)(ws + WS_WRU), DM, 32, nullptr, scr, r, lane); continue; } r -= I_SQ;
        if (r < I_SQ) { p0_transpose_item<0>(p.in[10], DM, (bf16_t*)(ws + WS_WPU), DM, 32, nullptr, scr, r, lane); continue; } r -= I_SQ;
        p0_transpose_item<0>(p.in[11], DM, (bf16_t*)(ws + WS_WO), DM, 32, nullptr, scr, r, lane);
    }
    const float* x = p.in[0]; bf16_t* XB = (bf16_t*)(ws + WS_S0); float* ss1 = (float*)(ws + WS_SS1);
    {
        f32x4 vn[4];
        if (gw < MTOK) { const f32x4* xr = (const f32x4*)(x + (size_t)gw * DM) + lane;
#pragma unroll
            for (int j = 0; j < 4; ++j) vn[j] = xr[64 * j]; }
        for (int m = gw; m < MTOK; m += NGW) {
            f32x4 v[4]; float s = 0.f;
#pragma unroll
            for (int j = 0; j < 4; ++j) v[j] = vn[j];
            if (m + NGW < MTOK) { const f32x4* xr = (const f32x4*)(x + (size_t)(m + NGW) * DM) + lane;
#pragma unroll
                for (int j = 0; j < 4; ++j) vn[j] = xr[64 * j]; }
#pragma unroll
            for (int j = 0; j < 4; ++j) s += (v[j][0] * v[j][0] + v[j][1] * v[j][1]) + (v[j][2] * v[j][2] + v[j][3] * v[j][3]);
#pragma unroll
            for (int o = 1; o < 64; o <<= 1) s += __shfl_xor(s, o);
            u32x2* o8 = (u32x2*)(XB + (size_t)m * DM) + lane;
#pragma unroll
            for (int j = 0; j < 4; ++j) { u32x2 w; w.x = pk2(v[j][0], v[j][1]); w.y = pk2(v[j][2], v[j][3]); o8[64 * j] = w; }
            if (lane == 0) ss1[m] = s;
        }
    }
    const int gt = blockIdx.x * 512 + tid, NGT = G * 512;
    float* cosT = (float*)(ws + WS_COS); float* sinT = (float*)(ws + WS_SIN);
    for (int i = gt; i < SEQ * 128; i += NGT) { const int pos = i >> 7, j = i & 127;
        const float inv = exp2f(-(float)j * (13.287712379549449f / 128.0f)); const float ang = (float)pos * inv;
        const double rev = (double)ang * 0.15915494309189533577; const float fr_ = (float)(rev - rint(rev));
        cosT[i] = __builtin_amdgcn_cosf(fr_); sinT[i] = __builtin_amdgcn_sinf(fr_); }
    float* z = (float*)(ws + WS_SS2);
    for (int i = gt; i < MTOK * 3 + MTOK * 4; i += NGT) z[i] = 0.f;
}

template <int O0, int O1, int O2, int O3>
__device__ __forceinline__ void tr4(unsigned addr, s16x4& a, s16x4& b, s16x4& c, s16x4& d) {
    asm volatile("ds_read_b64_tr_b16 %0, %4 offset:%5\n\tds_read_b64_tr_b16 %1, %4 offset:%6\n\tds_read_b64_tr_b16 %2, %4 offset:%7\n\tds_read_b64_tr_b16 %3, %4 offset:%8"
                 : "=&v"(a), "=&v"(b), "=&v"(c), "=&v"(d) : "v"(addr), "i"(O0), "i"(O1), "i"(O2), "i"(O3) : "memory");
}
__device__ __forceinline__ void tr_wait4(s16x4& a, s16x4& b, s16x4& c, s16x4& d) { asm volatile("s_waitcnt lgkmcnt(0)" : "+v"(a), "+v"(b), "+v"(c), "+v"(d) :: "memory"); }
__device__ __forceinline__ bf16x8 cat8(const s16x4 a, const s16x4 b) { bf16x8 r; r[0] = a[0]; r[1] = a[1]; r[2] = a[2]; r[3] = a[3]; r[4] = b[0]; r[5] = b[1]; r[6] = b[2]; r[7] = b[3]; return r; }
__device__ __forceinline__ unsigned short f2bf(float f) { unsigned u = __float_as_uint(f); u += 0x7fffu + ((u >> 16) & 1u); return (unsigned short)(u >> 16); }
__device__ __forceinline__ unsigned pk2s(float lo, float hi) { return pg8::cvt_pk_bf16(lo, hi); }

__device__ __forceinline__ void retention_phase(LAS unsigned char* lds, const bf16_t* Q, const bf16_t* Kb, const bf16_t* V, bf16_t* RET, float* ssr) {
    const int tid = threadIdx.x, wid = __builtin_amdgcn_readfirstlane(tid >> 6), lane = tid & 63, fr = lane & 15, fq = lane >> 4;
    constexpr int QP = 528, VP = 80, PP = 144;
    constexpr int OFF_Q = 0, OFF_K = 33792, OFF_V = 67584, OFF_VD = 72704, OFF_P = 77824, OFF_ST = 87040, ST_BYTES = 16896;
    const unsigned lbase = (unsigned)(size_t)lds;
    const int trq = fr >> 2, trp = fr & 3;
    for (int item = blockIdx.x; item < 256; item += gridDim.x) {
        const int xcd = item & 7, loc = item >> 3, bh = xcd * 4 + (loc >> 3), js = loc & 7, b = bh >> 2, h = bh & 3;
        const float lg = log2f(1.0f - exp2f(-5.0f - (float)h));
        const float cdec = __builtin_amdgcn_exp2f(lg * 64.0f);
        __syncthreads();
        for (int i = tid; i < ST_BYTES / 4; i += 512) ((LAS unsigned*)(lds + OFF_ST))[i] = 0u;
        f32x4 sacc[2][2];
#pragma unroll
        for (int a = 0; a < 2; ++a)
#pragma unroll
            for (int c = 0; c < 2; ++c) sacc[a][c] = (f32x4){0.f, 0.f, 0.f, 0.f};
        const size_t tok0 = (size_t)b * SEQ;
        u32x4 rq[4], rk[4], rv;
#define RET_LOAD(c) do { _Pragma("unroll") for (int _i = 0; _i < 4; ++_i) { const int pc = tid + 512 * _i, row = pc >> 5, ch = pc & 31; const size_t e = (tok0 + 64 * (c) + row) * DM + h * 256 + ch * 8; \
            rq[_i] = *(const u32x4*)(Q + e); rk[_i] = *(const u32x4*)(Kb + e); } \
            if (tid < 256) { const int row = tid >> 2, ch = tid & 3; rv = *(const u32x4*)(V + (tok0 + 64 * (c) + row) * DM + h * 256 + js * 32 + ch * 8); } } while (0)
        RET_LOAD(0);
        for (int c = 0; c < 64; ++c) {
            __syncthreads();
#pragma unroll
            for (int i = 0; i < 4; ++i) { const int pc = tid + 512 * i, row = pc >> 5, ch = pc & 31;
                *(LAS u32x4*)(lds + OFF_Q + row * QP + ch * 16) = rq[i]; *(LAS u32x4*)(lds + OFF_K + row * QP + ch * 16) = rk[i]; }
            if (tid < 256) { const int row = tid >> 2, ch = tid & 3; *(LAS u32x4*)(lds + OFF_V + row * VP + ch * 16) = rv;
                const float kd = __builtin_amdgcn_exp2f(lg * (float)(63 - row)); f32x4 a0, a1; unpack8(rv, a0, a1); a0 *= kd; a1 *= kd;
                u32x4 w; w.x = pk2s(a0[0], a0[1]); w.y = pk2s(a0[2], a0[3]); w.z = pk2s(a1[0], a1[1]); w.w = pk2s(a1[2], a1[3]);
                *(LAS u32x4*)(lds + OFF_VD + row * VP + ch * 16) = w; }
            if (c + 1 < 64) RET_LOAD(c + 1);
            __syncthreads();
            bf16x8 qfc[8];
            {
                const int r = wid >> 1, kb0 = 2 * (wid & 1);
                f32x4 sT[2] = {(f32x4){0.f, 0.f, 0.f, 0.f}, (f32x4){0.f, 0.f, 0.f, 0.f}};
#pragma unroll
                for (int ks = 0; ks < 8; ++ks) {
                    const bf16x8 qf = *(const LAS bf16x8*)(lds + OFF_Q + (16 * r + fr) * QP + (32 * ks + 8 * fq) * 2); qfc[ks] = qf;
#pragma unroll
                    for (int j = 0; j < 2; ++j) { const bf16x8 kf = *(const LAS bf16x8*)(lds + OFF_K + (16 * (kb0 + j) + fr) * QP + (32 * ks + 8 * fq) * 2);
                        sT[j] = __builtin_amdgcn_mfma_f32_16x16x32_bf16(kf, qf, sT[j], 0, 0, 0); }
                }
                const int n = 16 * r + fr;
#pragma unroll
                for (int j = 0; j < 2; ++j) { const int m0 = 16 * (kb0 + j) + 4 * fq; float pv[4];
#pragma unroll
                    for (int i = 0; i < 4; ++i) { const int d = n - (m0 + i); pv[i] = sT[j][i] * __builtin_amdgcn_exp2f(lg * (float)(d < 0 ? -d : d)); }
                    u32x2 w; w.x = pk2s(pv[0], pv[1]); w.y = pk2s(pv[2], pv[3]);
                    *(LAS u32x2*)(lds + OFF_P + n * PP + m0 * 2) = w; }
            }
            {
#pragma unroll
                for (int a = 0; a < 2; ++a)
#pragma unroll
                    for (int cc = 0; cc < 2; ++cc) sacc[a][cc] *= cdec;
                {
                    const int r0 = 8 * fq + trq;
                    s16x4 ta[2][4], tb[2][4];
#pragma unroll
                    for (int a = 0; a < 2; ++a) tr4<0, 4 * QP, 32 * QP, 36 * QP>(lbase + OFF_K + r0 * QP + (16 * (2 * wid + a) + 4 * trp) * 2, ta[a][0], ta[a][1], ta[a][2], ta[a][3]);
#pragma unroll
                    for (int cc = 0; cc < 2; ++cc) tr4<0, 4 * VP, 32 * VP, 36 * VP>(lbase + OFF_VD + r0 * VP + (16 * cc + 4 * trp) * 2, tb[cc][0], tb[cc][1], tb[cc][2], tb[cc][3]);
                    tr_wait4(ta[0][0], ta[0][1], ta[0][2], ta[0][3]); tr_wait4(ta[1][0], ta[1][1], ta[1][2], ta[1][3]);
                    tr_wait4(tb[0][0], tb[0][1], tb[0][2], tb[0][3]); tr_wait4(tb[1][0], tb[1][1], tb[1][2], tb[1][3]);
#pragma unroll
                    for (int ks = 0; ks < 2; ++ks)
#pragma unroll
                        for (int a = 0; a < 2; ++a)
#pragma unroll
                            for (int cc = 0; cc < 2; ++cc) sacc[a][cc] = __builtin_amdgcn_mfma_f32_16x16x32_bf16(cat8(ta[a][2 * ks], ta[a][2 * ks + 1]), cat8(tb[cc][2 * ks], tb[cc][2 * ks + 1]), sacc[a][cc], 0, 0, 0);
                }
                LAS unsigned char* stn = lds + OFF_ST + ((c + 1) & 1) * ST_BYTES;
#pragma unroll
                for (int a = 0; a < 2; ++a)
#pragma unroll
                    for (int cc = 0; cc < 2; ++cc) { u32x2 w; w.x = pk2s(sacc[a][cc][0], sacc[a][cc][1]); w.y = pk2s(sacc[a][cc][2], sacc[a][cc][3]);
                        *(LAS u32x2*)(stn + (16 * cc + fr) * QP + (16 * (2 * wid + a) + 4 * fq) * 2) = w; }
            }
            __syncthreads();
            {
                const int r = wid >> 1, cb = wid & 1;
                f32x4 ain = (f32x4){0.f, 0.f, 0.f, 0.f}, acr = (f32x4){0.f, 0.f, 0.f, 0.f};
                {
                    s16x4 tv[4];
                    tr4<0, 4 * VP, 32 * VP, 36 * VP>(lbase + OFF_V + (8 * fq + trq) * VP + (16 * cb + 4 * trp) * 2, tv[0], tv[1], tv[2], tv[3]);
                    bf16x8 pf[2];
#pragma unroll
                    for (int ks = 0; ks < 2; ++ks) pf[ks] = *(const LAS bf16x8*)(lds + OFF_P + (16 * r + fr) * PP + (32 * ks + 8 * fq) * 2);
                    tr_wait4(tv[0], tv[1], tv[2], tv[3]);
#pragma unroll
                    for (int ks = 0; ks < 2; ++ks) ain = __builtin_amdgcn_mfma_f32_16x16x32_bf16(cat8(tv[2 * ks], tv[2 * ks + 1]), pf[ks], ain, 0, 0, 0);
                }
                const LAS unsigned char* stc = lds + OFF_ST + (c & 1) * ST_BYTES;
#pragma unroll
                for (int ks = 0; ks < 8; ++ks) {
                    const bf16x8 qf = qfc[ks];
                    const bf16x8 sf = *(const LAS bf16x8*)(stc + (16 * cb + fr) * QP + (32 * ks + 8 * fq) * 2);
                    acr = __builtin_amdgcn_mfma_f32_16x16x32_bf16(sf, qf, acr, 0, 0, 0);
                }
                const int n = 16 * r + fr; const float qd = __builtin_amdgcn_exp2f(lg * (float)(n + 1));
                const f32x4 o = ain + acr * qd;
                const size_t t = tok0 + 64 * c + n;
                u32x2 w; w.x = pk2s(o[0], o[1]); w.y = pk2s(o[2], o[3]);
                *(u32x2*)(RET + t * DM + h * 256 + js * 32 + cb * 16 + 4 * fq) = w;
                float q = (o[0] * o[0] + o[1] * o[1]) + (o[2] * o[2] + o[3] * o[3]);
                q += __shfl_xor(q, 16); q += __shfl_xor(q, 32);
                if (fq == 0) atomicAdd(ssr + t * 4 + h, q);
            }
        }
#undef RET_LOAD
    }
}

__device__ __forceinline__ void mix_elementwise(const bf16_t* RET, bf16_t* RN, const bf16_t* GR, const float* ssr, const bf16_t* P, bf16_t* PL) {
    const int gt = blockIdx.x * 512 + threadIdx.x, NGT = gridDim.x * 512;
    constexpr int T = 32;
    for (int item = gt; item < 128 * (MTOK / T); item += NGT) {
        const int ch = item & 127, g = ch >> 5, w = 2 << g; const size_t t0 = (size_t)(item >> 7) * T; const int pos0 = (int)(t0 & (SEQ - 1));
        const size_t base = t0 * DM + ch * 8;
        f32x4 s0 = (f32x4){0.f, 0.f, 0.f, 0.f}, s1 = s0;
        for (int k = 1; k < w; ++k) if (pos0 - k >= 0) { f32x4 b0, b1; unpack8(*(const u32x4*)(P + base - (size_t)k * DM), b0, b1); s0 += b0; s1 += b1; }
        u32x4 pc = *(const u32x4*)(P + base), rc = *(const u32x4*)(RET + base), gc = *(const u32x4*)(GR + base), oc = (u32x4){0u, 0u, 0u, 0u};
        float sq = ssr[t0 * 4 + g];
        if (pos0 + 1 >= w) oc = *(const u32x4*)(P + base - (size_t)(w - 1) * DM);
        for (int j = 0; j < T; ++j) {
            const size_t off = base + (size_t)j * DM; const int pos = pos0 + j;
            const u32x4 pcur = pc, rcur = rc, gcur = gc, ocur = oc; const float sqc = sq;
            if (j + 1 < T) { pc = *(const u32x4*)(P + off + DM); rc = *(const u32x4*)(RET + off + DM); gc = *(const u32x4*)(GR + off + DM); sq = ssr[(t0 + j + 1) * 4 + g];
                if (pos + 2 >= w) oc = *(const u32x4*)(P + off + DM - (size_t)(w - 1) * DM); }
            f32x4 c0, c1; unpack8(pcur, c0, c1); s0 += c0; s1 += c1;
            const int cnt = (pos + 1) < w ? (pos + 1) : w; const float inv = 1.0f / (float)cnt;
            *(u32x4*)(PL + off) = pack8(s0 * inv - c0, s1 * inv - c1);
            if (pos + 1 >= w) { f32x4 o0, o1; unpack8(ocur, o0, o1); s0 -= o0; s1 -= o1; }
            const float rs = __builtin_amdgcn_rsqf(sqc * (1.0f / 256.0f) + EPS);
            f32x4 a0, a1, g0, g1; unpack8(rcur, a0, a1); unpack8(gcur, g0, g1);
            *(u32x4*)(RN + off) = pack8(a0 * rs * g0, a1 * rs * g1);
        }
    }
}

__device__ __forceinline__ void final_norm(const bf16_t* hin, float* out, const float* ss, const float* g) {
    const size_t gt = (size_t)blockIdx.x * 512 + threadIdx.x, NGT = (size_t)gridDim.x * 512, NI = (size_t)MTOK * 128;
    u32x4 hn = (u32x4){0u, 0u, 0u, 0u}; float sn = 1.f;
    if (gt < NI) { hn = *(const u32x4*)(hin + (gt >> 7) * DM + (gt & 127) * 8); sn = ss[gt >> 7]; }
    for (size_t i = gt; i < NI; i += NGT) {
        const size_t t = i >> 7; const int c8 = (int)(i & 127) * 8; const u32x4 hc = hn; const float rs = rs_of(sn);
        const size_t i2 = i + NGT;
        if (i2 < NI) { hn = *(const u32x4*)(hin + (i2 >> 7) * DM + (i2 & 127) * 8); sn = ss[i2 >> 7]; }
        f32x4 v0, v1; unpack8(hc, v0, v1);
        const f32x4 g0 = *(const f32x4*)(g + c8), g1 = *(const f32x4*)(g + c8 + 4);
        *(f32x4*)(out + t * DM + c8) = v0 * rs * g0; *(f32x4*)(out + t * DM + c8 + 4) = v1 * rs * g1;
    }
}

#define XB_TMO      128
#define XB_XCNT(j)  (256  + 64 * (j))
#define XB_XSUB(j)  (1280 + 64 * (j))
#define XB_XGEN(j)  (2304 + 64 * (j))
#define XB_TOP      3328
#define XB_TOPGEN   3392
#define XCD_BAR_WORDS 3456
#define XB_SPIN_CAP (1u << 18)
__device__ __forceinline__ unsigned xb_ld(unsigned* p)              { return __hip_atomic_load(p, __ATOMIC_RELAXED, __HIP_MEMORY_SCOPE_AGENT); }
__device__ __forceinline__ unsigned xb_add(unsigned* p, unsigned v) { return __hip_atomic_fetch_add(p, v, __ATOMIC_RELAXED, __HIP_MEMORY_SCOPE_AGENT); }
__device__ __forceinline__ unsigned xb_xcc_id() { return (unsigned)__builtin_amdgcn_s_getreg((3 << 11) | 20) & 0xFu; }
#define XB_SPIN(cond, bar) do { unsigned _sp = 0; while (cond) { __builtin_amdgcn_s_sleep(1); \
    if ((++_sp & 255u) == 0u) { if (xb_ld(&(bar)[XB_TMO])) break; if (_sp > XB_SPIN_CAP) { atomicAdd(&(bar)[XB_TMO], 1u); break; } } } } while (0)
struct XcdBarrier { unsigned* bar; unsigned x; volatile LAS unsigned* st; };
__device__ __forceinline__ XcdBarrier xcd_barrier_post(unsigned* bar, volatile LAS unsigned* st) {
    XcdBarrier b; b.bar = bar; b.x = xb_xcc_id(); b.st = st;
    if (threadIdx.x == 0) (void)xb_add(&bar[XB_XCNT(b.x)], 1u);
    return b;
}
__device__ __forceinline__ void xcd_barrier_complete(unsigned* bar, unsigned x, unsigned& nloc, unsigned& nx) {
    const unsigned G = gridDim.x * gridDim.y * gridDim.z;
    unsigned sum, cnt, mine, sp = 0u;
    for (;;) {
        sum = 0u; cnt = 0u; mine = 0u;
#pragma unroll
        for (unsigned j = 0; j < 16; ++j) { const unsigned c = xb_ld(&bar[XB_XCNT(j)]); sum += c; cnt += (c > 0u) ? 1u : 0u; mine = (j == x) ? c : mine; }
        if (sum == G) break;
        __builtin_amdgcn_s_sleep(1);
        if ((++sp & 255u) == 0u) { if (xb_ld(&bar[XB_TMO])) break; if (sp > XB_SPIN_CAP) { atomicAdd(&bar[XB_TMO], 1u); break; } }
    }
    nloc = mine > 0u ? mine : 1u; nx = cnt > 0u ? cnt : 1u;
}
__device__ __forceinline__ void xcd_barrier(const XcdBarrier& b) {
    asm volatile("s_waitcnt vmcnt(0)" ::: "memory");
    __syncthreads();
    if (threadIdx.x == 0) {
        unsigned* bar = b.bar;
        __builtin_amdgcn_s_waitcnt(0);
        unsigned nloc = b.st[0], nx = b.st[1];
        if (nloc == 0u) { xcd_barrier_complete(bar, b.x, nloc, nx); b.st[0] = nloc; b.st[1] = nx; }
        const unsigned old = xb_add(&bar[XB_XSUB(b.x)], 1u);
        const unsigned gen = old / nloc;
        if (old + 1u == (gen + 1u) * nloc) {
            __builtin_amdgcn_fence(__ATOMIC_RELEASE, "agent");
            asm volatile("s_waitcnt vmcnt(0)" ::: "memory");
            const unsigned og = xb_add(&bar[XB_TOP], 1u);
            const unsigned tg = og / nx;
            if (og + 1u == (tg + 1u) * nx) xb_add(&bar[XB_TOPGEN], 1u);
            else XB_SPIN(xb_ld(&bar[XB_TOPGEN]) == tg, bar);
            __builtin_amdgcn_fence(__ATOMIC_ACQUIRE, "agent");
            xb_add(&bar[XB_XGEN(b.x)], 1u);
            asm volatile("s_waitcnt vmcnt(0)" ::: "memory");
        } else {
            XB_SPIN(xb_ld(&bar[XB_XGEN(b.x)]) == gen, bar);
            __builtin_amdgcn_fence(__ATOMIC_ACQUIRE, "agent");
            asm volatile("s_waitcnt vmcnt(0)" ::: "memory");
        }
    }
    __syncthreads();
}
constexpr size_t WS_BAR = 62 * MiB;

constexpr int NPHASE = 13;
__global__ void __launch_bounds__(512, 2) fwd_megakernel(Params p) {
    extern __shared__ __attribute__((aligned(16))) unsigned char lds_raw[];
    LAS unsigned char* lds = (LAS unsigned char*)lds_raw;
    unsigned char* ws = p.ws;
    const int G = gridDim.x, c = blockIdx.x;
    bf16_t* S0 = (bf16_t*)(ws + WS_S0); bf16_t* S1 = (bf16_t*)(ws + WS_S1); bf16_t* BIG = (bf16_t*)(ws + WS_BIG);
    bf16_t* B0 = BIG; bf16_t* B1 = BIG + SLOT / 2; bf16_t* B2 = BIG + SLOT; bf16_t* B3 = BIG + 3 * (SLOT / 2);
    float* ss1 = (float*)(ws + WS_SS1); float* ss2 = (float*)(ws + WS_SS2); float* ss3 = (float*)(ws + WS_SS3); float* ss4 = (float*)(ws + WS_SS4); float* ssr = (float*)(ws + WS_SSR);
    const int lo = p.ph_lo, hi = p.ph_hi;
    volatile LAS unsigned* xst = (volatile LAS unsigned*)(lds + pg8::STAGE_BYTES);
    if (threadIdx.x < 4) xst[threadIdx.x] = 0u;
    __syncthreads();
    XcdBarrier xbar = xcd_barrier_post((unsigned*)(ws + WS_BAR), xst);
    bf16_t* OLO = (bf16_t*)p.out; bf16_t* OHI = (bf16_t*)p.out + SLOT / 2;
#ifndef ENMASK
#define ENMASK 0x1fff
#endif
#define IN(k) (((ENMASK >> (k)) & 1) && lo <= (k) && (k) < hi)
    if (p.ph_hi < 0) cg::this_grid().sync();
#define SEAM(k) do { if (IN(k) && IN((k) + 1)) xcd_barrier(xbar); } while (0)
#ifndef REPMASK
#define REPMASK 0
#endif
#define NREP(k) (((REPMASK >> (k)) & 1) ? 2 : 1)
    float* dss = (float*)(ws + 60 * MiB); bf16_t* DUMB = (bf16_t*)(ws + 448 * MiB);
    if (IN(0)) for (int rep = NREP(0); rep > 0; --rep) p0_prologue(p, lds);
    SEAM(0);
    if (IN(1)) {
        pg8::Gemm g{S0, (const bf16_t*)(ws + WS_W1A), DM, DM, DM, 0}; pg8::StaticOrder S; S.init(MTOK, 2 * DFF, G, c, NREP(1));
        EpiSwiglu E{BIG, ss1}; pg8::gemm_phase(lds, g, S, E);
    }
    SEAM(1);
    if (IN(2)) {
        pg8::Gemm g{BIG, (const bf16_t*)(ws + WS_W1B), DFF, DFF, DFF, 0}; pg8::StaticOrder S; S.init(MTOK, DM, G, c, NREP(2));
        EpiResid<true> E{p.in[0], OLO, ss2, 0.5f, DUMB, dss}; pg8::gemm_phase(lds, g, S, E);
    }
    SEAM(2);
    bf16_t* S7 = (bf16_t*)(ws + 448 * MiB);
#define RUN_QKV() do { pg8::Gemm g{OLO, (const bf16_t*)(ws + WS_WIN), DM, DM, DM, 0}; pg8::StaticOrder S; S.init(MTOK, 3072, G, c, NREP(3)); \
            EpiQKV E{BIG, ss2, (const float*)(ws + WS_COS), (const float*)(ws + WS_SIN)}; pg8::gemm_phase(lds, g, S, E); } while (0)
#define RUN_GATES(PART) do { pg8::Gemm g{OLO, (const bf16_t*)(ws + WS_WIN) + (size_t)(3072 + 2048 * (PART)) * DM, DM, DM, DM, 0}; pg8::StaticOrder S; S.init(MTOK, 2048, G, c, NREP(5)); \
            EpiGates E{ws, OHI, ss2, p.in[6], 8 * (PART)}; pg8::gemm_phase(lds, g, S, E); } while (0)
    if (IN(3)) {
        if ((c >> 3) & 1) { RUN_GATES(0); RUN_QKV(); } else { RUN_QKV(); RUN_GATES(0); }
    }
    SEAM(3);
    if (IN(4)) {
        if ((c >> 6) & 1) { RUN_GATES(1); __syncthreads(); retention_phase(lds, B0, B1, B2, S0, ssr); }
        else { retention_phase(lds, B0, B1, B2, S0, ssr); __syncthreads(); RUN_GATES(1); }
    }
#undef RUN_QKV
#undef RUN_GATES
    SEAM(4);
    if (IN(6)) for (int rep = NREP(6); rep > 0; --rep) mix_elementwise(S0, B0, B3, ssr, S1, B1);
    if (IN(5) && IN(6) && IN(7)) xcd_barrier(xbar);
    if (IN(7)) {
        {
            pg8::Gemm g{B1, (const bf16_t*)(ws + WS_WPL), DM, 256, 256, 256}; pg8::StaticOrder S; S.init(MTOK, DM, G, c, NREP(7));
            EpiScaleCol E{B2, p.in[8]}; pg8::gemm_phase(lds, g, S, E);
        }
        {
            pg8::Gemm g{B0, (const bf16_t*)(ws + WS_WRU), DM, DM, DM, 0}; pg8::StaticOrder S; S.init(MTOK, DM, G, c, NREP(7));
            EpiGateMul<false> E{S0, S7, nullptr}; pg8::gemm_phase(lds, g, S, E);
        }
    }
    SEAM(7);
    if (IN(8)) {
        pg8::Gemm g{B2, (const bf16_t*)(ws + WS_WPU), DM, DM, DM, 0}; pg8::StaticOrder S; S.init(MTOK, DM, G, c, NREP(8));
        EpiGateMul<true> E{S1, OHI, S0}; pg8::gemm_phase(lds, g, S, E);
    }
    SEAM(8);
    if (IN(9)) {
        pg8::Gemm g{S1, (const bf16_t*)(ws + WS_WO), DM, DM, DM, 0}; pg8::StaticOrder S; S.init(MTOK, DM, G, c, NREP(9));
        EpiResid<false> E{OLO, OHI, ss3, 1.0f, DUMB, dss}; pg8::gemm_phase(lds, g, S, E);
    }
    SEAM(9);
    if (IN(10)) {
        pg8::Gemm g{OHI, (const bf16_t*)(ws + WS_W2A), DM, DM, DM, 0}; pg8::StaticOrder S; S.init(MTOK, 2 * DFF, G, c, NREP(10));
        EpiSwiglu E{BIG, ss3}; pg8::gemm_phase(lds, g, S, E);
    }
    SEAM(10);
    if (IN(11)) {
        pg8::Gemm g{BIG, (const bf16_t*)(ws + WS_W2B), DFF, DFF, DFF, 0}; pg8::StaticOrder S; S.init(MTOK, DM, G, c, NREP(11));
        EpiResid<false> E{OHI, S1, ss4, 0.5f, DUMB, dss}; pg8::gemm_phase(lds, g, S, E);
    }
    SEAM(11);
    if (IN(12)) for (int rep = NREP(12); rep > 0; --rep) final_norm(S1, rep > 1 ? (float*)BIG : p.out, ss4, p.in[15]);
#undef IN
#undef SEAM
}

extern "C" void kernel_launch(void* const* d_in, const int* in_sizes, int n_in, void* d_out, int out_size, void* d_ws, size_t ws_size, hipStream_t stream) {
    constexpr int LDS_BYTES = pg8::STAGE_BYTES + 16;
    static int grid = 0;
    if (grid == 0) {
        if (n_in != 16 || out_size != MTOK * DM || ws_size < WS_END) { fprintf(stderr, "kernel_launch: unexpected shapes (n_in %d out %d ws %zu)\n", n_in, out_size, ws_size); grid = -1; return; }
        int dev = 0, cus = 0, per_cu = 0;
        (void)hipGetDevice(&dev); (void)hipDeviceGetAttribute(&cus, hipDeviceAttributeMultiprocessorCount, dev);
        if (hipFuncSetAttribute((const void*)fwd_megakernel, hipFuncAttributeMaxDynamicSharedMemorySize, LDS_BYTES) != hipSuccess) { fprintf(stderr, "kernel_launch: hipFuncSetAttribute failed\n"); grid = -1; return; }
        if (hipOccupancyMaxActiveBlocksPerMultiprocessor(&per_cu, (const void*)fwd_megakernel, 512, LDS_BYTES) != hipSuccess || per_cu < 1) { fprintf(stderr, "kernel_launch: occupancy query gave %d\n", per_cu); per_cu = 1; }
        (void)hipGetLastError();
        grid = cus;
    }
    if (grid < 0) return;
    if (hipMemsetAsync((char*)d_ws + WS_BAR, 0, XCD_BAR_WORDS * 4, stream) != hipSuccess) { fprintf(stderr, "kernel_launch: memset failed\n"); return; }
    Params p{};
    for (int i = 0; i < 16; ++i) p.in[i] = (const float*)d_in[i];
    p.out = (float*)d_out; p.ws = (unsigned char*)d_ws;
#if N_LAUNCH_MODE == 1
    p.ph_lo = 0; p.ph_hi = NPHASE;
    void* args[] = {&p};
    hipError_t e = hipLaunchCooperativeKernel((const void*)fwd_megakernel, dim3(grid), dim3(512), args, LDS_BYTES, stream);
    if (e != hipSuccess) fprintf(stderr, "cooperative launch failed: %s (grid %d)\n", hipGetErrorString(e), grid);
#else
    for (int ph = 0; ph < NPHASE; ++ph) { p.ph_lo = ph; p.ph_hi = ph + 1; hipLaunchKernelGGL(fwd_megakernel, dim3(grid), dim3(512), LDS_BYTES, stream, p); }
#endif
}
```
